# Optimizing an MI355X kernel written in HIP

```python
import math
import jax, jax.numpy as jnp
from jax import lax
import numpy as np

D_MODEL = 1024
BATCH = 4
SEQ = 8192
DEPTH = 1

CHUNK = 64
Q_BLOCK = 128
SB_HEADS = 8
SB_HEAD_DIM = 64
SB_WIDTH = SB_HEADS * SB_HEAD_DIM
CA_HEADS = 8
CA_HEAD_DIM = 64
CA_WIDTH = CA_HEADS * CA_HEAD_DIM
CA_LEFT_CHUNKS = 8
CA_BAND = (CA_LEFT_CHUNKS + 1) * CHUNK
CA_PAD = CA_LEFT_CHUNKS * CHUNK
REL_CLIP = 128
N_REL = 2 * REL_CLIP + 1
IN_COLS = 3 * SB_WIDTH + 3 * CA_WIDTH + 2 * D_MODEL
PEER_HEADS = 8
PEER_N_KEYS = 128
PEER_N_EXPERTS = PEER_N_KEYS * PEER_N_KEYS
PEER_QUERY_DIM = 256
PEER_HALF = PEER_QUERY_DIM // 2
PEER_TOPK = 16
PEER_TOKEN_BLOCK = 128
RMS_EPS = 1e-6
NEG_INF = -1e30

kernel_name = "hybrid_stickbreak_chunkattn_peer"


def rmsnorm(x, g):
    xf = x.astype(jnp.float32)
    y = xf * lax.rsqrt(jnp.mean(xf * xf, axis=-1, keepdims=True) + RMS_EPS)
    return (y * g.astype(jnp.float32)).astype(x.dtype)


def split_in_proj(p):
    widths = (SB_WIDTH,) * 3 + (CA_WIDTH,) * 3 + (D_MODEL, D_MODEL)
    cuts = np.cumsum(widths)[:-1].tolist()
    return jnp.split(p, cuts, axis=-1)


def stick_breaking_attention(q, k, v):
    B, S, H, Dh = q.shape
    scale = 1.0 / math.sqrt(Dh)
    kf = k.astype(jnp.float32)
    vf = v.astype(jnp.float32)
    key_pos = jnp.arange(S)

    def one_block(i):
        start = i * Q_BLOCK
        qb = lax.dynamic_slice_in_dim(q, start, Q_BLOCK, axis=1).astype(jnp.float32)
        z = jnp.einsum('bqhd,bkhd->bhqk', qb, kf) * scale
        qpos = start + jnp.arange(Q_BLOCK)
        causal = (key_pos[None, :] < qpos[:, None])[None, None]
        log_1m = jnp.where(causal, jax.nn.log_sigmoid(-z), 0.0)
        after = lax.cumsum(log_1m, axis=3, reverse=True) - log_1m
        w = jnp.where(causal, jnp.exp(jax.nn.log_sigmoid(z) + after), 0.0)
        return jnp.einsum('bhqk,bkhd->bqhd', w, vf)

    out = lax.map(one_block, jnp.arange(S // Q_BLOCK))
    return jnp.moveaxis(out, 0, 1).reshape(B, S, H, Dh)


def chunked_rel_attention(q, k, v, rel_table):
    B, S, H, Dh = q.shape
    scale = 1.0 / math.sqrt(Dh)
    kp = jnp.pad(k, ((0, 0), (CA_PAD, 0), (0, 0), (0, 0)))
    vp = jnp.pad(v, ((0, 0), (CA_PAD, 0), (0, 0), (0, 0)))
    rel = jnp.arange(CHUNK)[:, None] + CA_PAD - jnp.arange(CA_BAND)[None, :]
    bias = rel_table.astype(jnp.float32)[:, jnp.clip(rel, -REL_CLIP, REL_CLIP) + REL_CLIP]

    def one_chunk(c):
        start = c * CHUNK
        qc = lax.dynamic_slice_in_dim(q, start, CHUNK, axis=1).astype(jnp.float32)
        kb = lax.dynamic_slice_in_dim(kp, start, CA_BAND, axis=1).astype(jnp.float32)
        vb = lax.dynamic_slice_in_dim(vp, start, CA_BAND, axis=1).astype(jnp.float32)
        s = jnp.einsum('bqhd,bkhd->bhqk', qc, kb) * scale + bias[None]
        valid = (start - CA_PAD + jnp.arange(CA_BAND)) >= 0
        s = jnp.where(valid[None, None, None, :], s, NEG_INF)
        p = jax.nn.softmax(s, axis=-1)
        return jnp.einsum('bhqk,bkhd->bqhd', p, vb)

    out = lax.map(one_chunk, jnp.arange(S // CHUNK))
    return jnp.moveaxis(out, 0, 1).reshape(B, S, H, Dh)


def peer_ffn(h, w_query, sub_keys, expert_u, expert_v):
    B, S, D = h.shape
    tokens = h.reshape(B * S // PEER_TOKEN_BLOCK, PEER_TOKEN_BLOCK, D)
    keys_f = sub_keys.astype(jnp.float32)

    def one_block(xb):
        xf = xb.astype(jnp.float32)
        q = (xb @ w_query).astype(jnp.float32).reshape(PEER_TOKEN_BLOCK, PEER_HEADS, 2, PEER_HALF)
        scores = jnp.einsum('thpc,hpnc->thpn', q, keys_f)
        top_v, top_i = lax.top_k(scores, PEER_TOPK)
        cand_v = (top_v[:, :, 0, :, None] + top_v[:, :, 1, None, :]).reshape(
            PEER_TOKEN_BLOCK, PEER_HEADS, PEER_TOPK * PEER_TOPK)
        cand_i = (top_i[:, :, 0, :, None] * PEER_N_KEYS + top_i[:, :, 1, None, :]).reshape(
            PEER_TOKEN_BLOCK, PEER_HEADS, PEER_TOPK * PEER_TOPK)
        best_v, best_pos = lax.top_k(cand_v, PEER_TOPK)
        expert_idx = jnp.take_along_axis(cand_i, best_pos, axis=-1)
        g = jax.nn.softmax(best_v, axis=-1)
        u = expert_u[expert_idx].astype(jnp.float32)
        a = jax.nn.gelu(jnp.einsum('thkd,td->thk', u, xf), approximate=False)
        vsel = expert_v[expert_idx].astype(jnp.float32)
        return jnp.einsum('thk,thkd->td', g * a, vsel).astype(xb.dtype)

    out = lax.map(one_block, tokens)
    return out.reshape(B, S, D)


def setup_inputs(seed: int = 0) -> dict:
    key = jax.random.key(seed)
    ks = jax.random.split(key, 16)
    f32 = jnp.float32
    nrm = lambda k, shape, s: jax.random.normal(k, shape, f32) * s
    return {
        "x": nrm(ks[0], (BATCH, SEQ, D_MODEL), 1.0),
        "norm_mix": 1.0 + nrm(ks[1], (DEPTH, D_MODEL), 0.02),
        "w_in": nrm(ks[2], (DEPTH, D_MODEL, IN_COLS), D_MODEL ** -0.5),
        "w_sb_proj": nrm(ks[3], (DEPTH, SB_WIDTH, D_MODEL), SB_WIDTH ** -0.5),
        "w_ca_proj": nrm(ks[4], (DEPTH, CA_WIDTH, D_MODEL), CA_WIDTH ** -0.5),
        "ca_rel_bias": nrm(ks[5], (DEPTH, CA_HEADS, N_REL), 0.5),
        "w_out": nrm(ks[6], (DEPTH, D_MODEL, D_MODEL), D_MODEL ** -0.5),
        "norm_ffn": 1.0 + nrm(ks[7], (DEPTH, D_MODEL), 0.02),
        "peer_w_query": nrm(ks[8], (DEPTH, D_MODEL, PEER_HEADS * PEER_QUERY_DIM), D_MODEL ** -0.5),
        "peer_sub_keys": nrm(ks[9], (DEPTH, PEER_HEADS, 2, PEER_N_KEYS, PEER_HALF), PEER_HALF ** -0.5),
        "peer_u": nrm(ks[10], (DEPTH, PEER_N_EXPERTS, D_MODEL), D_MODEL ** -0.5),
        "peer_v": nrm(ks[11], (DEPTH, PEER_N_EXPERTS, D_MODEL), 0.5),
        "norm_final": 1.0 + nrm(ks[12], (D_MODEL,), 0.02),
    }


def reference(x, norm_mix, w_in, w_sb_proj, w_ca_proj, ca_rel_bias, w_out, norm_ffn,
              peer_w_query, peer_sub_keys, peer_u, peer_v, norm_final):
    B, S, _ = x.shape
    for layer in range(DEPTH):
        h = rmsnorm(x, norm_mix[layer])
        proj = h @ w_in[layer]
        q_sb, k_sb, v_sb, q_ca, k_ca, v_ca, gate_sb, gate_ca = split_in_proj(proj)
        sb4 = lambda t: t.reshape(B, S, SB_HEADS, SB_HEAD_DIM)
        ca4 = lambda t: t.reshape(B, S, CA_HEADS, CA_HEAD_DIM)
        o_sb = stick_breaking_attention(sb4(q_sb), sb4(k_sb), sb4(v_sb)).reshape(B, S, SB_WIDTH)
        o_ca = chunked_rel_attention(ca4(q_ca), ca4(k_ca), ca4(v_ca),
                                     ca_rel_bias[layer]).reshape(B, S, CA_WIDTH)
        br_sb = (o_sb.astype(x.dtype) @ w_sb_proj[layer]).astype(jnp.float32)
        br_ca = (o_ca.astype(x.dtype) @ w_ca_proj[layer]).astype(jnp.float32)
        merged = (jax.nn.sigmoid(gate_sb.astype(jnp.float32)) * br_sb
                  + jax.nn.sigmoid(gate_ca.astype(jnp.float32)) * br_ca)
        x = x + merged.astype(x.dtype) @ w_out[layer]
        h2 = rmsnorm(x, norm_ffn[layer])
        x = x + peer_ffn(h2, peer_w_query[layer], peer_sub_keys[layer],
                         peer_u[layer], peer_v[layer])
    return rmsnorm(x, norm_final)
```

```cpp
#include <hip/hip_runtime.h>
#include <hip/hip_cooperative_groups.h>
#include <cstdio>
#include <cstdint>
namespace cg = cooperative_groups;
namespace pg8 {
#define PG8_LAS __attribute__((address_space(3)))
typedef unsigned short bf16_t;
typedef short bf16x8 __attribute__((ext_vector_type(8)));
typedef float f32x4 __attribute__((ext_vector_type(4)));
typedef unsigned u32x4 __attribute__((ext_vector_type(4)));
constexpr int BM = 256, BK = 64, HALF = 128, HTB = HALF * BK * 2  , STAGE_BYTES = 8 * HTB, NXCD = 8, WGM = 8;

__host__ __device__ __forceinline__ int lds_byte(int r, int c) { const int st = (r >> 4) * 2 + (c >> 5), rr = r & 15, cc = c & 31, ob = rr * 64 + cc * 2; return st * 1024 + (ob ^ (((ob >> 9) & 1) << 5)); }
__host__ __device__ __forceinline__ void stage_rc(int b, int& R, int& C) { const int st = b / 1024, sb = b % 1024, swz = sb ^ (((sb >> 9) & 1) << 5); R = (st >> 1) * 16 + swz / 64; C = (st & 1) * 32 + (swz % 64) / 2; }
__host__ __device__ __forceinline__ int perm32(int rho) { const int n = rho >> 4, i = rho & 15; return 8 * (i >> 2) + 4 * n + (i & 3); }

struct Unit { int pm, pn; };
struct Gemm { const bf16_t* A; const bf16_t* Bt; int M, N, K; };

struct StaticOrder {
    int nM, nN, nwg, G, c;
    __host__ __device__ void init(int M, int N, int G_, int c_) { nM = M / BM; nN = N / BM; nwg = nM * nN; G = G_; c = c_; }
    __host__ __device__ bool next(int i, Unit& u) const {
        const long L = (long)i * G + c; if (L >= nwg) return false;
        int wgid = (int)L; { const int q = nwg / NXCD, r = nwg % NXCD, xcd = wgid % NXCD, off = wgid / NXCD; wgid = (xcd < r ? xcd * (q + 1) : r * (q + 1) + (xcd - r) * q) + off; }
        const int nig = WGM * nN, gid = wgid / nig, fm = gid * WGM, gsz = (nM - fm) < WGM ? (nM - fm) : WGM;
        u.pm = fm + ((wgid % nig) % gsz); u.pn = (wgid % nig) / gsz; return true;
    }
    __device__ __forceinline__ void a_ready(const Unit&) const {}
    __device__ __forceinline__ void done(const Unit&) const {}
};

__device__ __forceinline__ unsigned cvt_pk_bf16(float lo, float hi) { unsigned r; asm volatile("v_cvt_pk_bf16_f32 %0, %1, %2" : "=v"(r) : "v"(lo), "v"(hi)); return r; }
typedef float f32x2 __attribute__((ext_vector_type(2)));
__device__ __forceinline__ f32x2 gelu_pk(f32x2 v) {
    const f32x2 av = __builtin_elementwise_abs(v), d = av * 0.2316418882f + 1.0f;
    f32x2 t; t.x = __builtin_amdgcn_rcpf(d.x); t.y = __builtin_amdgcn_rcpf(d.y);
    f32x2 q = t * 0.5307027145f + (-0.7265760135f); q = q * t + 0.7107068705f; q = q * t + (-0.142248368f); q = q * t + 0.127414796f; q = q * t;
    const f32x2 s = (v * v) * (-0.72134752044f);
    f32x2 e; e.x = __builtin_amdgcn_exp2f(s.x); e.y = __builtin_amdgcn_exp2f(s.y);
    const f32x2 m = v * (q * e), r = v - m;
    f32x2 o; o.x = v.x < 0.f ? m.x : r.x; o.y = v.y < 0.f ? m.y : r.y; return o;
}

template <int ACT  > struct EpiBf16 {
    static constexpr bool PERM = true, AFTER_DRAIN = false; static_assert(ACT == 0 || ACT == 1, "EpiBf16: ACT is 0 (none) or 1 (gelu_pk)");
    bf16_t* O; int ldc; const float* bias; int split_cols; size_t split_stride; float scale0;
    __device__ __forceinline__ void operator()(const f32x4 (&acc)[2][2][4][2], const Unit& u, int wr, int wc, int fr, int fq) const {
        const int row0 = u.pm * BM + wr * 64 + fr; int colt = u.pn * BM; bf16_t* base = O;
        float sc = 1.f; if (split_cols) { const int t = colt / split_cols; base += (size_t)t * split_stride; colt -= t * split_cols; if (t == 0) sc = scale0; }
        const int col0 = colt + wc * 32 + 8 * fq, bcol0 = u.pn * BM + wc * 32 + 8 * fq;
        f32x4 bv[2][2];
#pragma unroll
        for (int bj = 0; bj < 2; ++bj)
#pragma unroll
            for (int n = 0; n < 2; ++n) bv[bj][n] = bias ? *(const f32x4*)(bias + bcol0 + bj * HALF + 4 * n) : (f32x4){0.f, 0.f, 0.f, 0.f};
#pragma unroll
        for (int ai = 0; ai < 2; ++ai)
#pragma unroll
            for (int m = 0; m < 4; ++m) { bf16_t* rowp = base + (size_t)(row0 + ai * HALF + m * 16) * ldc + col0;
#pragma unroll
                for (int bj = 0; bj < 2; ++bj) { f32x4 v0 = acc[ai][bj][m][0] + bv[bj][0], v1 = acc[ai][bj][m][1] + bv[bj][1];
                    if (ACT == 1) { f32x2 a = gelu_pk((f32x2){v0[0], v0[1]}), b = gelu_pk((f32x2){v0[2], v0[3]}), c = gelu_pk((f32x2){v1[0], v1[1]}), d = gelu_pk((f32x2){v1[2], v1[3]});
                        v0 = (f32x4){a.x, a.y, b.x, b.y}; v1 = (f32x4){c.x, c.y, d.x, d.y}; }
                    v0 = v0 * sc; v1 = v1 * sc; u32x4 w; w.x = cvt_pk_bf16(v0[0], v0[1]); w.y = cvt_pk_bf16(v0[2], v0[3]); w.z = cvt_pk_bf16(v1[0], v1[1]); w.w = cvt_pk_bf16(v1[2], v1[3]);
                    *(u32x4*)(rowp + bj * HALF) = w; } }
    }
};
template <class E, class = void> struct has_midk { static constexpr bool value = false; };
template <class E> struct has_midk<E, decltype((void)E::MIDK)> { static constexpr bool value = E::MIDK; };
template <class Epi, class Sched, bool ALIGN_EPI = false, bool SP2 = false>
__device__ __forceinline__ void gemm_phase(PG8_LAS unsigned char* lds, const Gemm g, const Sched& S, const Epi& E) {
    int tid_ = threadIdx.x; asm volatile("" : "+v"(tid_));
    const int tid = tid_, wid = __builtin_amdgcn_readfirstlane(tid >> 6), lane = tid & 63, wr = wid >> 2, wc = wid & 3, fr = lane & 15, fq = lane >> 4;
    const int K = g.K, nt = K / BK;
    unsigned voffA[2], voffB[2];
#pragma unroll
    for (int i = 0; i < 2; ++i) { int R, C; stage_rc(tid * 16 + i * 8192, R, C); const int Rb = Epi::PERM ? ((R & ~31) + perm32(R & 31)) : R;
        voffA[i] = (unsigned)(R * K + C) * 2u; voffB[i] = (unsigned)(Rb * K + C) * 2u; }
    const size_t kstep = (size_t)(BK * 2);
    const size_t hstep = (size_t)HALF * K * 2;
    const size_t tstep = 2 * hstep;
    const unsigned ldsw = (unsigned)wid * 1024u;
    const int aoff = lds_byte(wr * 64 + fr, fq * 8), boff = lds_byte(wc * 32 + fr, fq * 8);
#define PG8_SA(b, h) (((b) * 2 + (h)) * HTB)
#define PG8_SB(b, h) ((4 + (b) * 2 + (h)) * HTB)
#define PG8_STAGE(bufoff, gbase, voff) do { _Pragma("unroll") for (int _i = 0; _i < 2; ++_i) \
        __builtin_amdgcn_global_load_lds((const unsigned*)((const char*)(gbase) + (voff)[_i]), (PG8_LAS unsigned*)(lds + (bufoff) + ldsw + _i * 8192), 16, 0, 0); } while (0)
#define PG8_LDA(dst, b, h) do { _Pragma("unroll") for (int m = 0; m < 4; ++m) _Pragma("unroll") for (int k = 0; k < 2; ++k) dst[m][k] = *(const PG8_LAS bf16x8*)(lds + PG8_SA(b, h) + aoff + m * 2048 + k * 1024); } while (0)
#define PG8_LDB(dst, b, h) do { _Pragma("unroll") for (int n = 0; n < 2; ++n) _Pragma("unroll") for (int k = 0; k < 2; ++k) dst[n][k] = *(const PG8_LAS bf16x8*)(lds + PG8_SB(b, h) + boff + n * 2048 + k * 1024); } while (0)
#define PG8_MMA(ai, bj, At, Bt) do { __builtin_amdgcn_s_setprio(1); _Pragma("unroll") for (int m = 0; m < 4; ++m) _Pragma("unroll") for (int n = 0; n < 2; ++n) _Pragma("unroll") for (int k = 0; k < 2; ++k) \
        acc[ai][bj][m][n] = __builtin_amdgcn_mfma_f32_16x16x32_bf16(Bt[n][k], At[m][k], acc[ai][bj][m][n], 0, 0, 0); __builtin_amdgcn_s_setprio(0); } while (0)
#define PG8_WAIT_V(n) asm volatile("s_waitcnt vmcnt(" #n ")" ::: "memory")
#define PG8_WAIT_L(n) asm volatile("s_waitcnt lgkmcnt(" #n ")" ::: "memory")
#define PG8_BAR __builtin_amdgcn_s_barrier()
#define PG8_SCHED __builtin_amdgcn_sched_barrier(0)
    Unit cur, nxt; int ui = 0;
    if (!S.next(0, cur)) return;
    f32x4 acc[2][2][4][2];
#pragma unroll
    for (int a = 0; a < 2; ++a)
#pragma unroll
        for (int b = 0; b < 2; ++b)
#pragma unroll
            for (int m = 0; m < 4; ++m)
#pragma unroll
                for (int n = 0; n < 2; ++n) acc[a][b][m][n] = (f32x4){0.f, 0.f, 0.f, 0.f};
    bf16x8 At[4][2], B0[2][2], B1[2][2];
    const char* cA = (const char*)g.A + (size_t)cur.pm * tstep; const char* cB = (const char*)g.Bt + (size_t)cur.pn * tstep;
    S.a_ready(cur);
    if constexpr (SP2) {
        PG8_STAGE(PG8_SB(0, 0), cB, voffB); PG8_STAGE(PG8_SB(0, 1), cB + hstep, voffB); PG8_STAGE(PG8_SA(0, 0), cA, voffA); PG8_STAGE(PG8_SA(0, 1), cA + hstep, voffA);
        if (wr == 1) PG8_BAR;
        PG8_WAIT_V(2); PG8_BAR;
        PG8_STAGE(PG8_SB(1, 0), cB + kstep, voffB); PG8_STAGE(PG8_SA(1, 0), cA + kstep, voffA); PG8_STAGE(PG8_SB(1, 1), cB + hstep + kstep, voffB);
        PG8_WAIT_V(6); PG8_BAR;
    } else {
        PG8_STAGE(PG8_SB(0, 0), cB, voffB); PG8_STAGE(PG8_SA(0, 0), cA, voffA); PG8_STAGE(PG8_SB(0, 1), cB + hstep, voffB); PG8_STAGE(PG8_SA(0, 1), cA + hstep, voffA);
        if (wr == 1) PG8_BAR;
        PG8_WAIT_V(4); PG8_BAR;
        PG8_STAGE(PG8_SB(1, 0), cB + kstep, voffB); PG8_STAGE(PG8_SA(1, 0), cA + kstep, voffA); PG8_STAGE(PG8_SB(1, 1), cB + hstep + kstep, voffB);
        PG8_WAIT_V(6); PG8_BAR;
    }
    for (;;) {
        const bool has_next = S.next(ui + 1, nxt);
        const char* nA = has_next ? (const char*)g.A + (size_t)nxt.pm * tstep : cA; const char* nB = has_next ? (const char*)g.Bt + (size_t)nxt.pn * tstep : cB;
        constexpr int NSEG = has_midk<Epi>::value ? 2 : 1;
        for (int seg = 0; seg < NSEG; ++seg) {
        if constexpr (has_midk<Epi>::value) { if (seg == 1) E.mid(acc, cur, wr, wc, fr, fq); }
        for (int t = seg * (nt / NSEG); t < (seg + 1) * (nt / NSEG); t += 2) {
            const bool last = (t == nt - 2);
            const char* a1 = cA + (size_t)(t + 1) * kstep;
            const char* a2 = last ? nA : cA + (size_t)(t + 2) * kstep; const char* b2 = last ? nB : cB + (size_t)(t + 2) * kstep;
            const char* a3 = a2 + kstep; const char* b3 = b2 + kstep;
            if (last && has_next) S.a_ready(nxt);
            if constexpr (SP2) {
            PG8_LDB(B0, 0, 0); PG8_LDB(B1, 0, 1); PG8_SCHED; PG8_LDA(At, 0, 0); PG8_STAGE(PG8_SA(1, 1), a1 + hstep, voffA);
            PG8_WAIT_V(8); PG8_WAIT_L(0); PG8_BAR; PG8_MMA(0, 0, At, B0); PG8_MMA(0, 1, At, B1); PG8_BAR; PG8_SCHED;
            PG8_LDA(At, 0, 1); PG8_STAGE(PG8_SB(0, 0), b2, voffB); PG8_STAGE(PG8_SB(0, 1), b2 + hstep, voffB); PG8_STAGE(PG8_SA(0, 0), a2, voffA);
            PG8_WAIT_V(8); PG8_WAIT_L(0); PG8_BAR; PG8_MMA(1, 0, At, B0); PG8_MMA(1, 1, At, B1); PG8_BAR; PG8_SCHED;
            PG8_LDB(B0, 1, 0); PG8_LDB(B1, 1, 1); PG8_SCHED; PG8_LDA(At, 1, 0); PG8_STAGE(PG8_SA(0, 1), a2 + hstep, voffA);
            PG8_WAIT_V(8); PG8_WAIT_L(0); PG8_BAR; PG8_MMA(0, 0, At, B0); PG8_MMA(0, 1, At, B1); PG8_BAR; PG8_SCHED;
            PG8_LDA(At, 1, 1); PG8_STAGE(PG8_SB(1, 0), b3, voffB); PG8_STAGE(PG8_SB(1, 1), b3 + hstep, voffB); PG8_STAGE(PG8_SA(1, 0), a3, voffA);
            PG8_WAIT_V(8); PG8_WAIT_L(0); PG8_BAR; PG8_MMA(1, 0, At, B0); PG8_MMA(1, 1, At, B1); PG8_BAR; PG8_SCHED;
            } else {
            PG8_LDB(B0, 0, 0); PG8_SCHED; PG8_LDA(At, 0, 0); PG8_STAGE(PG8_SA(1, 1), a1 + hstep, voffA);
            PG8_WAIT_L(8); PG8_BAR; PG8_WAIT_L(0); PG8_MMA(0, 0, At, B0); PG8_BAR; PG8_SCHED;
            PG8_LDB(B1, 0, 1); PG8_STAGE(PG8_SB(0, 0), b2, voffB);
            PG8_BAR; PG8_WAIT_L(0); PG8_MMA(0, 1, At, B1); PG8_BAR;
            PG8_LDA(At, 0, 1); PG8_STAGE(PG8_SA(0, 0), a2, voffA);
            PG8_BAR; PG8_WAIT_L(0); PG8_MMA(1, 0, At, B0); PG8_BAR; PG8_SCHED;
            PG8_STAGE(PG8_SB(0, 1), b2 + hstep, voffB);
            PG8_WAIT_V(6); PG8_BAR; PG8_MMA(1, 1, At, B1); PG8_BAR;
            PG8_LDB(B0, 1, 0); PG8_SCHED; PG8_LDA(At, 1, 0); PG8_STAGE(PG8_SA(0, 1), a2 + hstep, voffA);
            PG8_WAIT_L(8); PG8_BAR; PG8_WAIT_L(0); PG8_MMA(0, 0, At, B0); PG8_BAR; PG8_SCHED;
            PG8_LDB(B1, 1, 1); PG8_STAGE(PG8_SB(1, 0), b3, voffB);
            PG8_BAR; PG8_WAIT_L(0); PG8_MMA(0, 1, At, B1); PG8_BAR;
            PG8_LDA(At, 1, 1); PG8_STAGE(PG8_SA(1, 0), a3, voffA);
            PG8_BAR; PG8_WAIT_L(0); PG8_MMA(1, 0, At, B0); PG8_BAR; PG8_SCHED;
            PG8_STAGE(PG8_SB(1, 1), b3 + hstep, voffB);
            PG8_WAIT_V(6); PG8_BAR; PG8_MMA(1, 1, At, B1); PG8_BAR;
            }
        }
        }
        if constexpr (ALIGN_EPI) { if (wr == 0) PG8_BAR; }
        if constexpr (!Epi::AFTER_DRAIN) { E(acc, cur, wr, wc, fr, fq); S.done(cur); }
        if (!has_next) break;
#pragma unroll
        for (int a = 0; a < 2; ++a)
#pragma unroll
            for (int b = 0; b < 2; ++b)
#pragma unroll
                for (int m = 0; m < 4; ++m)
#pragma unroll
                    for (int n = 0; n < 2; ++n) acc[a][b][m][n] = (f32x4){0.f, 0.f, 0.f, 0.f};
        cur = nxt; cA = nA; cB = nB; ++ui;
        if constexpr (ALIGN_EPI) { if (wr == 1) PG8_BAR; }
    }
    PG8_WAIT_V(0);
    if constexpr (!ALIGN_EPI) { if (wr == 0) PG8_BAR; }
    PG8_BAR;
    if constexpr (Epi::AFTER_DRAIN) { E.fused(acc, cur, wr, wc, fr, fq, lds, wid, lane); S.done(cur); }
#undef PG8_SA
#undef PG8_SB
#undef PG8_STAGE
#undef PG8_LDA
#undef PG8_LDB
#undef PG8_MMA
#undef PG8_WAIT_V
#undef PG8_WAIT_L
#undef PG8_BAR
#undef PG8_SCHED
}
}

constexpr int D = 1024, BATCH = 4, SEQ = 8192, T = BATCH * SEQ;
constexpr int NWAVES = 8, NTHREADS = NWAVES * 64;
constexpr float RMS_EPS = 1e-6f;
constexpr float LOG2E = 1.4426950408889634f;
constexpr float QSCALE = 0.125f * LOG2E;

#define LAS __attribute__((address_space(3)))
typedef unsigned short bf16;
typedef unsigned u32x4 __attribute__((ext_vector_type(4)));
typedef unsigned u32x2 __attribute__((ext_vector_type(2)));
typedef float f32x4 __attribute__((ext_vector_type(4)));

constexpr size_t MiB = 1u << 20;
constexpr size_t WS_SSQ = 1 * MiB;
constexpr size_t WS_WIN = 3 * MiB;
constexpr size_t WS_PSB = 13 * MiB;
constexpr size_t WS_PCA = 14 * MiB;
constexpr size_t WS_WOUT = 15 * MiB;
constexpr size_t WS_WSC = 17 * MiB;
constexpr size_t WS_U = 21 * MiB;
constexpr size_t WS_V = 37 * MiB;
constexpr size_t WS_SU = 53 * MiB;
constexpr size_t WS_SV = 53 * MiB + 65536;
constexpr size_t WS_RSTD = 53 * MiB + 131072;
constexpr size_t WS_SSQ2 = 54 * MiB;
constexpr size_t WS_IDX = 85 * MiB;
constexpr size_t WS_GW = 101 * MiB;
constexpr size_t WS_SLOT0 = 120 * MiB;
constexpr size_t SLOT = 64 * MiB;
constexpr size_t WS_END = WS_SLOT0 + 6 * SLOT;
constexpr int LDS_BYTES = 147456;
constexpr int LDS_BIAS_OFF = 131072;
constexpr int LDS_MISC_OFF = 143360;

__device__ __forceinline__ float bf_lo(unsigned u) { return __uint_as_float(u << 16); }
__device__ __forceinline__ float bf_hi(unsigned u) { return __uint_as_float(u & 0xffff0000u); }
__device__ __forceinline__ unsigned f2bf(float f) { unsigned u = __float_as_uint(f); return (u + 0x7fffu + ((u >> 16) & 1u)) >> 16; }
typedef __bf16 bf16x2_t __attribute__((ext_vector_type(2)));
typedef float f32x2 __attribute__((ext_vector_type(2)));
__device__ __forceinline__ unsigned pk2(float lo, float hi) { const f32x2 v = {lo, hi}; return __builtin_bit_cast(unsigned, __builtin_convertvector(v, bf16x2_t)); }
__device__ __forceinline__ float dot2bf(unsigned a, unsigned b, float c) { return __builtin_amdgcn_fdot2_f32_bf16(__builtin_bit_cast(bf16x2_t, a), __builtin_bit_cast(bf16x2_t, b), c, false); }
__device__ __forceinline__ float wave_sum(float v) {
    v += __int_as_float(__builtin_amdgcn_mov_dpp(__float_as_int(v), 0xB1, 0xf, 0xf, true));
    v += __int_as_float(__builtin_amdgcn_mov_dpp(__float_as_int(v), 0x4E, 0xf, 0xf, true));
    v += __int_as_float(__builtin_amdgcn_mov_dpp(__float_as_int(v), 0x141, 0xf, 0xf, true));
    v += __int_as_float(__builtin_amdgcn_mov_dpp(__float_as_int(v), 0x140, 0xf, 0xf, true));
    { const auto r = __builtin_amdgcn_permlane16_swap(__float_as_uint(v), __float_as_uint(v), false, false); v = __uint_as_float(r[0]) + __uint_as_float(r[1]); }
    { const auto r = __builtin_amdgcn_permlane32_swap(__float_as_uint(v), __float_as_uint(v), false, false); v = __uint_as_float(r[0]) + __uint_as_float(r[1]); }
    return v;
}
__device__ __forceinline__ float fexp2(float x) { return __builtin_amdgcn_exp2f(x); }
__device__ __forceinline__ float flog2(float x) { return __builtin_amdgcn_logf(x); }
__device__ __forceinline__ float sigmoidf_fast(float x) { return __builtin_amdgcn_rcpf(1.f + fexp2(-x * LOG2E)); }

__device__ __forceinline__ u32x4 gate8(const u32x4 g, const pg8::f32x4 v0, const pg8::f32x4 v1) {
    u32x4 w;
    w.x = pg8::cvt_pk_bf16(sigmoidf_fast(bf_lo(g.x)) * v0[0], sigmoidf_fast(bf_hi(g.x)) * v0[1]);
    w.y = pg8::cvt_pk_bf16(sigmoidf_fast(bf_lo(g.y)) * v0[2], sigmoidf_fast(bf_hi(g.y)) * v0[3]);
    w.z = pg8::cvt_pk_bf16(sigmoidf_fast(bf_lo(g.z)) * v1[0], sigmoidf_fast(bf_hi(g.z)) * v1[1]);
    w.w = pg8::cvt_pk_bf16(sigmoidf_fast(bf_lo(g.w)) * v1[2], sigmoidf_fast(bf_hi(g.w)) * v1[3]);
    return w;
}
__device__ __forceinline__ u32x4 gate8_add(const u32x4 g, const u32x4 p, const pg8::f32x4 v0, const pg8::f32x4 v1) {
    u32x4 w;
    w.x = pg8::cvt_pk_bf16(bf_lo(p.x) + sigmoidf_fast(bf_lo(g.x)) * v0[0], bf_hi(p.x) + sigmoidf_fast(bf_hi(g.x)) * v0[1]);
    w.y = pg8::cvt_pk_bf16(bf_lo(p.y) + sigmoidf_fast(bf_lo(g.y)) * v0[2], bf_hi(p.y) + sigmoidf_fast(bf_hi(g.y)) * v0[3]);
    w.z = pg8::cvt_pk_bf16(bf_lo(p.z) + sigmoidf_fast(bf_lo(g.z)) * v1[0], bf_hi(p.z) + sigmoidf_fast(bf_hi(g.z)) * v1[1]);
    w.w = pg8::cvt_pk_bf16(bf_lo(p.w) + sigmoidf_fast(bf_lo(g.w)) * v1[2], bf_hi(p.w) + sigmoidf_fast(bf_hi(g.w)) * v1[3]);
    return w;
}
__device__ __forceinline__ void pack_acc_half(u32x4 (&pk)[2][4], const pg8::f32x4 (&acc)[2][2][4][2], int ai) {
#pragma unroll
    for (int bj = 0; bj < 2; ++bj)
#pragma unroll
        for (int m = 0; m < 4; ++m) { const pg8::f32x4 v0 = acc[ai][bj][m][0], v1 = acc[ai][bj][m][1];
            pk[bj][m] = (u32x4){pg8::cvt_pk_bf16(v0[0], v0[1]), pg8::cvt_pk_bf16(v0[2], v0[3]), pg8::cvt_pk_bf16(v1[0], v1[1]), pg8::cvt_pk_bf16(v1[2], v1[3])}; }
}
__device__ __forceinline__ u32x4 gate8p(const u32x4 g, const u32x4 a) {
    u32x4 w;
    w.x = pg8::cvt_pk_bf16(sigmoidf_fast(bf_lo(g.x)) * bf_lo(a.x), sigmoidf_fast(bf_hi(g.x)) * bf_hi(a.x));
    w.y = pg8::cvt_pk_bf16(sigmoidf_fast(bf_lo(g.y)) * bf_lo(a.y), sigmoidf_fast(bf_hi(g.y)) * bf_hi(a.y));
    w.z = pg8::cvt_pk_bf16(sigmoidf_fast(bf_lo(g.z)) * bf_lo(a.z), sigmoidf_fast(bf_hi(g.z)) * bf_hi(a.z));
    w.w = pg8::cvt_pk_bf16(sigmoidf_fast(bf_lo(g.w)) * bf_lo(a.w), sigmoidf_fast(bf_hi(g.w)) * bf_hi(a.w));
    return w;
}
__device__ __forceinline__ u32x4 gate8p_add(const u32x4 g, const u32x4 p, const u32x4 a) {
    u32x4 w;
    w.x = pg8::cvt_pk_bf16(bf_lo(p.x) + sigmoidf_fast(bf_lo(g.x)) * bf_lo(a.x), bf_hi(p.x) + sigmoidf_fast(bf_hi(g.x)) * bf_hi(a.x));
    w.y = pg8::cvt_pk_bf16(bf_lo(p.y) + sigmoidf_fast(bf_lo(g.y)) * bf_lo(a.y), bf_hi(p.y) + sigmoidf_fast(bf_hi(g.y)) * bf_hi(a.y));
    w.z = pg8::cvt_pk_bf16(bf_lo(p.z) + sigmoidf_fast(bf_lo(g.z)) * bf_lo(a.z), bf_hi(p.z) + sigmoidf_fast(bf_hi(g.z)) * bf_hi(a.z));
    w.w = pg8::cvt_pk_bf16(bf_lo(p.w) + sigmoidf_fast(bf_lo(g.w)) * bf_lo(a.w), bf_hi(p.w) + sigmoidf_fast(bf_hi(g.w)) * bf_hi(a.w));
    return w;
}
struct EpiGateA {
    static constexpr bool PERM = true, AFTER_DRAIN = false;
    const bf16* gate; bf16* out;
    __device__ __forceinline__ void operator()(const pg8::f32x4 (&acc)[2][2][4][2], const pg8::Unit& u, int wr, int wc, int fr, int fq) const {
        const size_t ro0 = (size_t)(u.pm * 256 + wr * 64 + fr) * 1024 + u.pn * 256 + wc * 32 + 8 * fq;
        u32x4 pk[2][2][4];
        pack_acc_half(pk[0], acc, 0); pack_acc_half(pk[1], acc, 1);
        u32x4 g[2][2][4];
#pragma unroll
        for (int ai = 0; ai < 2; ++ai)
#pragma unroll
            for (int bj = 0; bj < 2; ++bj)
#pragma unroll
                for (int m = 0; m < 4; ++m) g[ai][bj][m] = *(const u32x4*)(gate + ro0 + (size_t)(ai * 128 + m * 16) * 1024 + bj * 128);
#pragma unroll
        for (int ai = 0; ai < 2; ++ai)
#pragma unroll
            for (int bj = 0; bj < 2; ++bj)
#pragma unroll
                for (int m = 0; m < 4; ++m) *(u32x4*)(out + ro0 + (size_t)(ai * 128 + m * 16) * 1024 + bj * 128) = gate8p(g[ai][bj][m], pk[ai][bj][m]);
    }
};
__device__ __forceinline__ float gate_ratio(float xs, float xc) { return (1.f + fexp2(-fmaxf(xc, -80.f) * LOG2E)) * __builtin_amdgcn_rcpf(1.f + fexp2(-xs * LOG2E)); }
__device__ __forceinline__ float sigmoid_c80(float x) { return __builtin_amdgcn_rcpf(1.f + fexp2(-fmaxf(x, -80.f) * LOG2E)); }
struct EpiGateAB {
    static constexpr bool PERM = true, AFTER_DRAIN = false, MIDK = true;
    const bf16* gsb; const bf16* gca; bf16* out;
    __device__ __forceinline__ void batch_load(u32x4 (&a)[4], u32x4 (&b)[4], __amdgpu_buffer_rsrc_t rs, __amdgpu_buffer_rsrc_t rc, unsigned voff, unsigned soff) const {
#pragma unroll
        for (int m = 0; m < 4; ++m) { a[m] = __builtin_bit_cast(u32x4, __builtin_amdgcn_raw_buffer_load_b128(rs, voff, soff + (unsigned)(m * 16 * 1024 * 2), 0));
                                      b[m] = __builtin_bit_cast(u32x4, __builtin_amdgcn_raw_buffer_load_b128(rc, voff, soff + (unsigned)(m * 16 * 1024 * 2), 0)); }
    }
    __device__ __forceinline__ void batch_apply(pg8::f32x4 (&blk)[4][2], const u32x4 (&a)[4], const u32x4 (&b)[4]) const {
#pragma unroll
        for (int m = 0; m < 4; ++m) { pg8::f32x4& v0 = blk[m][0]; pg8::f32x4& v1 = blk[m][1];
            v0[0] *= gate_ratio(bf_lo(a[m].x), bf_lo(b[m].x)); v0[1] *= gate_ratio(bf_hi(a[m].x), bf_hi(b[m].x)); v0[2] *= gate_ratio(bf_lo(a[m].y), bf_lo(b[m].y)); v0[3] *= gate_ratio(bf_hi(a[m].y), bf_hi(b[m].y));
            v1[0] *= gate_ratio(bf_lo(a[m].z), bf_lo(b[m].z)); v1[1] *= gate_ratio(bf_hi(a[m].z), bf_hi(b[m].z)); v1[2] *= gate_ratio(bf_lo(a[m].w), bf_lo(b[m].w)); v1[3] *= gate_ratio(bf_hi(a[m].w), bf_hi(b[m].w)); }
    }
    __device__ __forceinline__ void mid(pg8::f32x4 (&acc)[2][2][4][2], const pg8::Unit& u, int wr, int wc, int fr, int fq) const {
        const __amdgpu_buffer_rsrc_t rs = __builtin_amdgcn_make_buffer_rsrc((void*)gsb, (short)0, T * 1024 * 2, 0x00020000), rc = __builtin_amdgcn_make_buffer_rsrc((void*)gca, (short)0, T * 1024 * 2, 0x00020000);
        const unsigned voff = (unsigned)((wr * 64 + fr) * 1024 + wc * 32 + 8 * fq) * 2u;
        const unsigned sb = (unsigned)(u.pm * 256 * 1024 + u.pn * 256) * 2u;
        u32x4 a0[4], b0[4], a1[4], b1[4];
        batch_load(a0, b0, rs, rc, voff, sb);                                    asm volatile("" ::: "memory");
        batch_load(a1, b1, rs, rc, voff, sb + 128u * 2u);                        asm volatile("" ::: "memory");
        batch_apply(acc[0][0], a0, b0);
        batch_load(a0, b0, rs, rc, voff, sb + 128u * 1024u * 2u);                asm volatile("" ::: "memory");
        batch_apply(acc[0][1], a1, b1);
        batch_load(a1, b1, rs, rc, voff, sb + 128u * 1024u * 2u + 128u * 2u);    asm volatile("" ::: "memory");
        batch_apply(acc[1][0], a0, b0);
        batch_apply(acc[1][1], a1, b1);
    }
    __device__ __forceinline__ void operator()(const pg8::f32x4 (&acc)[2][2][4][2], const pg8::Unit& u, int wr, int wc, int fr, int fq) const {
        const size_t ro0 = (size_t)(u.pm * 256 + wr * 64 + fr) * 1024 + u.pn * 256 + wc * 32 + 8 * fq;
#pragma unroll
        for (int ai = 0; ai < 2; ++ai) {
            u32x4 g[2][4];
#pragma unroll
            for (int bj = 0; bj < 2; ++bj)
#pragma unroll
                for (int m = 0; m < 4; ++m) g[bj][m] = *(const u32x4*)(gca + ro0 + (size_t)(ai * 128 + m * 16) * 1024 + bj * 128);
#pragma unroll
            for (int bj = 0; bj < 2; ++bj)
#pragma unroll
                for (int m = 0; m < 4; ++m) { const pg8::f32x4 v0 = acc[ai][bj][m][0], v1 = acc[ai][bj][m][1]; const u32x4 gg = g[bj][m]; u32x4 w;
                    w.x = pg8::cvt_pk_bf16(sigmoid_c80(bf_lo(gg.x)) * v0[0], sigmoid_c80(bf_hi(gg.x)) * v0[1]); w.y = pg8::cvt_pk_bf16(sigmoid_c80(bf_lo(gg.y)) * v0[2], sigmoid_c80(bf_hi(gg.y)) * v0[3]);
                    w.z = pg8::cvt_pk_bf16(sigmoid_c80(bf_lo(gg.z)) * v1[0], sigmoid_c80(bf_hi(gg.z)) * v1[1]); w.w = pg8::cvt_pk_bf16(sigmoid_c80(bf_lo(gg.w)) * v1[2], sigmoid_c80(bf_hi(gg.w)) * v1[3]);
                    *(u32x4*)(out + ro0 + (size_t)(ai * 128 + m * 16) * 1024 + bj * 128) = w; }
        }
    }
};
struct EpiGateB {
    static constexpr bool PERM = true, AFTER_DRAIN = false;
    const bf16* gate; const bf16* m1; bf16* out;
    __device__ __forceinline__ void operator()(const pg8::f32x4 (&acc)[2][2][4][2], const pg8::Unit& u, int wr, int wc, int fr, int fq) const {
        const size_t ro0 = (size_t)(u.pm * 256 + wr * 64 + fr) * 1024 + u.pn * 256 + wc * 32 + 8 * fq;
        u32x4 pk[2][2][4];
        pack_acc_half(pk[0], acc, 0); pack_acc_half(pk[1], acc, 1);
#pragma unroll
        for (int ai = 0; ai < 2; ++ai) {
            u32x4 g[2][4], p[2][4];
#pragma unroll
            for (int bj = 0; bj < 2; ++bj)
#pragma unroll
                for (int m = 0; m < 4; ++m) { const size_t ro = ro0 + (size_t)(ai * 128 + m * 16) * 1024 + bj * 128; g[bj][m] = *(const u32x4*)(gate + ro); p[bj][m] = *(const u32x4*)(m1 + ro); }
#pragma unroll
            for (int bj = 0; bj < 2; ++bj)
#pragma unroll
                for (int m = 0; m < 4; ++m) *(u32x4*)(out + ro0 + (size_t)(ai * 128 + m * 16) * 1024 + bj * 128) = gate8p_add(g[bj][m], p[bj][m], pk[ai][bj][m]);
        }
    }
};
struct EpiResid {
    static constexpr bool PERM = true, AFTER_DRAIN = false;
    const bf16* xb; bf16* x1b; float* ssq;
    __device__ __forceinline__ void operator()(const pg8::f32x4 (&acc)[2][2][4][2], const pg8::Unit& u, int wr, int wc, int fr, int fq) const {
        const int row0 = u.pm * 256 + wr * 64 + fr;
        const size_t ro0 = (size_t)row0 * 1024 + u.pn * 256 + wc * 32 + 8 * fq;
        u32x4 pk[2][2][4];
        pack_acc_half(pk[0], acc, 0); pack_acc_half(pk[1], acc, 1);
        u32x4 xq[2][2][4];
#pragma unroll
        for (int ai = 0; ai < 2; ++ai)
#pragma unroll
            for (int bj = 0; bj < 2; ++bj)
#pragma unroll
                for (int m = 0; m < 4; ++m) xq[ai][bj][m] = *(const u32x4*)(xb + ro0 + (size_t)(ai * 128 + m * 16) * 1024 + bj * 128);
#pragma unroll
        for (int ai = 0; ai < 2; ++ai)
#pragma unroll
            for (int m = 0; m < 4; ++m) {
                const int row = row0 + ai * 128 + m * 16;
                float ss = 0.f;
#pragma unroll
                for (int bj = 0; bj < 2; ++bj) {
                    const u32x4 xv = xq[ai][bj][m], a = pk[ai][bj][m];
                    u32x4 w; w.x = pk2(bf_lo(xv.x) + bf_lo(a.x), bf_hi(xv.x) + bf_hi(a.x)); w.y = pk2(bf_lo(xv.y) + bf_lo(a.y), bf_hi(xv.y) + bf_hi(a.y));
                    w.z = pk2(bf_lo(xv.z) + bf_lo(a.z), bf_hi(xv.z) + bf_hi(a.z)); w.w = pk2(bf_lo(xv.w) + bf_lo(a.w), bf_hi(xv.w) + bf_hi(a.w));
                    *(u32x4*)(x1b + ro0 + (size_t)(ai * 128 + m * 16) * 1024 + bj * 128) = w;
                    const float q0 = bf_lo(w.x), q1 = bf_hi(w.x), q2 = bf_lo(w.y), q3 = bf_hi(w.y), q4 = bf_lo(w.z), q5 = bf_hi(w.z), q6 = bf_lo(w.w), q7 = bf_hi(w.w);
                    ss += ((q0 * q0 + q1 * q1) + (q2 * q2 + q3 * q3)) + ((q4 * q4 + q5 * q5) + (q6 * q6 + q7 * q7));
                }
                ss += __shfl_xor(ss, 16); ss += __shfl_xor(ss, 32);
                if (fq == 0) ssq[(size_t)row * 16 + u.pn * 4 + wc] = ss;
            }
    }
};
typedef _Float16 f16x2_t __attribute__((ext_vector_type(2)));
struct EpiScore {
    static constexpr bool PERM = true, AFTER_DRAIN = false;
    const LAS float* rl; unsigned short* out; mutable int ord;
    __device__ __forceinline__ void operator()(const pg8::f32x4 (&acc)[2][2][4][2], const pg8::Unit& u, int wr, int wc, int fr, int fq) const {
        const int row0 = u.pm * 256 + wr * 64 + fr, col0 = u.pn * 256 + wc * 32 + 8 * fq;
        const LAS float* rp = rl + 256 * ord + wr * 64 + fr; ++ord;
#pragma unroll
        for (int ai = 0; ai < 2; ++ai)
#pragma unroll
            for (int m = 0; m < 4; ++m) {
                const int row = row0 + ai * 128 + m * 16;
                const float rstd = rp[ai * 128 + m * 16];
                const size_t ro = ((size_t)((row >> 6) * 8 + u.pn) * 32 + (wc * 4 + fq)) * 512 + (size_t)(row & 63) * 8;
#pragma unroll
                for (int bj = 0; bj < 2; ++bj) { const pg8::f32x4 v0 = acc[ai][bj][m][0] * rstd, v1 = acc[ai][bj][m][1] * rstd; u32x4 w;
                    w.x = __builtin_bit_cast(unsigned, __builtin_amdgcn_cvt_pkrtz(v0[0], v0[1])); w.y = __builtin_bit_cast(unsigned, __builtin_amdgcn_cvt_pkrtz(v0[2], v0[3]));
                    w.z = __builtin_bit_cast(unsigned, __builtin_amdgcn_cvt_pkrtz(v1[0], v1[1])); w.w = __builtin_bit_cast(unsigned, __builtin_amdgcn_cvt_pkrtz(v1[2], v1[3]));
                    *(u32x4*)(out + ro + bj * (16 * 512)) = w; }
            }
    }
};

typedef short bf16x8 __attribute__((ext_vector_type(8)));
typedef short s16x4 __attribute__((ext_vector_type(4)));
typedef short v4i16_t __attribute__((ext_vector_type(4)));
typedef float f32x16 __attribute__((ext_vector_type(16)));
#define MFMA32(a, b, c) __builtin_amdgcn_mfma_f32_32x32x16_bf16((a), (b), (c), 0, 0, 0)

__device__ __forceinline__ void p0_transpose_item(const float* W, int K, int N, bf16* WT, LAS float* scr, int item, int lane, int ld = 0) {
    if (ld == 0) ld = K;
    const int nblk = N / 32, kb = item / nblk, nb = item % nblk, k0 = 64 * kb, n0 = 32 * nb;
#pragma unroll 8
    for (int i = 0; i < 32; ++i) { const int kk = 2 * i + (lane >> 5); scr[kk * 33 + (lane & 31)] = W[(size_t)(k0 + kk) * N + n0 + (lane & 31)]; }
    asm volatile("s_waitcnt lgkmcnt(0)" ::: "memory");
    const int c = lane & 7;
#pragma unroll
    for (int j = 0; j < 4; ++j) { const int n = (lane >> 3) + 8 * j; const LAS float* s = scr + (8 * c) * 33 + n;
        u32x4 o; o.x = pk2(s[0 * 33], s[1 * 33]); o.y = pk2(s[2 * 33], s[3 * 33]); o.z = pk2(s[4 * 33], s[5 * 33]); o.w = pk2(s[6 * 33], s[7 * 33]);
        *(u32x4*)(WT + (size_t)(n0 + n) * ld + k0 + 8 * c) = o; }
    asm volatile("s_waitcnt lgkmcnt(0)" ::: "memory");
}
__device__ __forceinline__ void split_frag(const f32x4 a, const f32x4 b, bf16x8& hi, bf16x8& lo) {
    u32x4 ph, pl;
    ph.x = pk2(a.x, a.y); ph.y = pk2(a.z, a.w); ph.z = pk2(b.x, b.y); ph.w = pk2(b.z, b.w);
    pl.x = pk2(a.x - bf_lo(ph.x), a.y - bf_hi(ph.x)); pl.y = pk2(a.z - bf_lo(ph.y), a.w - bf_hi(ph.y));
    pl.z = pk2(b.x - bf_lo(ph.z), b.y - bf_hi(ph.z)); pl.w = pk2(b.z - bf_lo(ph.w), b.w - bf_hi(ph.w));
    hi = __builtin_bit_cast(bf16x8, ph); lo = __builtin_bit_cast(bf16x8, pl);
}
__device__ __forceinline__ void p0_wsc_item(const float* Wq, const float* keys, const float* g2, bf16* Wsc, int item, int lane) {
    const int nb = item & 3, kb = (item >> 2) & 31, g = item >> 7;
    const int r = lane & 31, h = lane >> 5;
    const float* ap = Wq + (size_t)(kb * 32 + r) * 2048 + g * 128 + 8 * h;
    const float* bp = keys + ((size_t)g * 128 + nb * 32 + r) * 128 + 8 * h;
    f32x16 d;
#pragma unroll
    for (int i = 0; i < 16; ++i) d[i] = 0.f;
#pragma unroll
    for (int ks = 0; ks < 8; ++ks) {
        bf16x8 ah, al, bh, bl;
        split_frag(*(const f32x4*)(ap + 16 * ks), *(const f32x4*)(ap + 16 * ks + 4), ah, al);
        split_frag(*(const f32x4*)(bp + 16 * ks), *(const f32x4*)(bp + 16 * ks + 4), bh, bl);
        d = MFMA32(ah, bh, d); d = MFMA32(ah, bl, d); d = MFMA32(al, bh, d);
    }
    bf16* op = Wsc + (size_t)(g * 128 + nb * 32 + r) * 1024 + kb * 32 + 4 * h;
    const float* gp = g2 + kb * 32 + 4 * h;
#pragma unroll
    for (int q = 0; q < 4; ++q) { const f32x4 gs = *(const f32x4*)(gp + 8 * q); u32x2 w;
        w.x = pk2(d[4 * q] * gs.x, d[4 * q + 1] * gs.y); w.y = pk2(d[4 * q + 2] * gs.z, d[4 * q + 3] * gs.w);
        *(u32x2*)(op + 8 * q) = w; }
}
__device__ __forceinline__ void row_load16(f32x4 (&v)[4], const float* xrow, int lane) {
    const f32x4* xr = (const f32x4*)xrow + lane;
#pragma unroll
    for (int j = 0; j < 4; ++j) v[j] = xr[64 * j];
}
__device__ __forceinline__ void rms_row_finish(const f32x4 (&v)[4], const float* g, bf16* orow, bf16* xbrow, int lane) {
    const f32x4* gr = (const f32x4*)g + lane;
    { unsigned long long* x8 = (unsigned long long*)xbrow + lane;
#pragma unroll
      for (int j = 0; j < 4; ++j) x8[64 * j] = (unsigned long long)pk2(v[j].x, v[j].y) | ((unsigned long long)pk2(v[j].z, v[j].w) << 32); }
    float s = 0.f;
#pragma unroll
    for (int j = 0; j < 4; ++j) s += (v[j].x * v[j].x + v[j].y * v[j].y) + (v[j].z * v[j].z + v[j].w * v[j].w);
    const float rstd = rsqrtf(wave_sum(s) * (1.f / D) + RMS_EPS);
    unsigned long long* o8 = (unsigned long long*)orow + lane;
#pragma unroll
    for (int j = 0; j < 4; ++j) { const f32x4 gv = gr[64 * j];
        o8[64 * j] = (unsigned long long)pk2(v[j].x * rstd * gv.x, v[j].y * rstd * gv.y) | ((unsigned long long)pk2(v[j].z * rstd * gv.z, v[j].w * rstd * gv.w) << 32); }
}

__device__ __forceinline__ s16x4 vtr(const LAS unsigned char* p) { return __builtin_bit_cast(s16x4, __builtin_amdgcn_ds_read_tr16_b64_v4i16((LAS v4i16_t*)p)); }
template <int S> __device__ __forceinline__ bf16x8 pack8(const f32x16& x) {
    u32x4 p; p.x = pk2(x[8 * S], x[8 * S + 1]); p.y = pk2(x[8 * S + 2], x[8 * S + 3]); p.z = pk2(x[8 * S + 4], x[8 * S + 5]); p.w = pk2(x[8 * S + 6], x[8 * S + 7]);
    return __builtin_bit_cast(bf16x8, p);
}
template <int S> __device__ __forceinline__ void split8(const f32x16& x, bf16x8& hi, bf16x8& lo) {
    u32x4 ph, pl;
#pragma unroll
    for (int j = 0; j < 4; ++j) {
        const unsigned hb = pk2(x[8 * S + 2 * j], x[8 * S + 2 * j + 1]);
        ph[j] = hb; pl[j] = pk2(x[8 * S + 2 * j] - bf_lo(hb), x[8 * S + 2 * j + 1] - bf_hi(hb));
    }
    hi = __builtin_bit_cast(bf16x8, ph); lo = __builtin_bit_cast(bf16x8, pl);
}
__device__ __forceinline__ void load_kfrag(bf16x8 (&kf)[4], const bf16* Kp, size_t row0, int lane) {
    const bf16* kp = Kp + (row0 + (lane & 31)) * 1024 + 8 * (lane >> 5);
#pragma unroll
    for (int ks = 0; ks < 4; ++ks) kf[ks] = *(const bf16x8*)(kp + 16 * ks);
}
__device__ __forceinline__ void load_vregs(u32x4 (&vr)[4], const bf16* Vp, size_t row0, int lane) {
#pragma unroll
    for (int i = 0; i < 4; ++i) { const int p = lane + 64 * i; vr[i] = *(const u32x4*)(Vp + (row0 + (p >> 3)) * 1024 + (p & 7) * 8); }
}
__device__ __forceinline__ void store_vlds(LAS unsigned char* vl, const u32x4 (&vr)[4], int lane) {
#pragma unroll
    for (int i = 0; i < 4; ++i) { const int p = lane + 64 * i; *(LAS u32x4*)(vl + (p >> 3) * 128 + (p & 7) * 16) = vr[i]; }
}
__device__ __forceinline__ void pv_block(f32x16 (&o)[2], const LAS unsigned char* vl, const bf16x8 p0, const bf16x8 p1, int lane) {
    const int i16 = lane & 15, h = lane >> 5;
    const unsigned base = (unsigned)(__UINTPTR_TYPE__)(vl + (4 * h + (i16 >> 2)) * 128 + (16 * ((lane >> 4) & 1) + 4 * (i16 & 3)) * 2);
    s16x4 t0, t1, t2, t3, t4, t5, t6, t7;
    asm volatile("ds_read_b64_tr_b16 %0, %8\n\tds_read_b64_tr_b16 %1, %8 offset:1024\n\tds_read_b64_tr_b16 %2, %8 offset:2048\n\tds_read_b64_tr_b16 %3, %8 offset:3072\n\t"
                 "ds_read_b64_tr_b16 %4, %8 offset:64\n\tds_read_b64_tr_b16 %5, %8 offset:1088\n\tds_read_b64_tr_b16 %6, %8 offset:2112\n\tds_read_b64_tr_b16 %7, %8 offset:3136\n\t"
                 "s_waitcnt lgkmcnt(0)"
                 : "=&v"(t0), "=&v"(t1), "=&v"(t2), "=&v"(t3), "=&v"(t4), "=&v"(t5), "=&v"(t6), "=&v"(t7) : "v"(base) : "memory");
    __builtin_amdgcn_sched_barrier(0);
    o[0] = MFMA32(__builtin_shufflevector(t0, t1, 0, 1, 2, 3, 4, 5, 6, 7), p0, o[0]);
    o[0] = MFMA32(__builtin_shufflevector(t2, t3, 0, 1, 2, 3, 4, 5, 6, 7), p1, o[0]);
    o[1] = MFMA32(__builtin_shufflevector(t4, t5, 0, 1, 2, 3, 4, 5, 6, 7), p0, o[1]);
    o[1] = MFMA32(__builtin_shufflevector(t6, t7, 0, 1, 2, 3, 4, 5, 6, 7), p1, o[1]);
}
__device__ __forceinline__ void store_ot(const f32x16 (&o)[2], float sc, bf16* op, int h) {
#pragma unroll
    for (int db = 0; db < 2; ++db)
#pragma unroll
        for (int g = 0; g < 4; ++g) { u32x2 w; w.x = pk2(o[db][4 * g] * sc, o[db][4 * g + 1] * sc); w.y = pk2(o[db][4 * g + 2] * sc, o[db][4 * g + 3] * sc);
            *(u32x2*)(op + 32 * db + 8 * g + 4 * h) = w; }
}
constexpr int ATT_SLOT = 16384, ATT_NSLOT = 4, ATT_RING = ATT_NSLOT * ATT_SLOT, ATT_FLAGS = ATT_RING;
__device__ __forceinline__ void att_dma(LAS unsigned char* slot, const bf16* Kp, const bf16* Vp, size_t row0, int wave, int lane) {
    const int r = 8 * (wave & 3) + (lane >> 3), p = lane & 7;
    const bf16* src = (wave < 4) ? Kp + (row0 + r) * 1024 + ((p ^ ((r >> 1) & 7)) * 8) : Vp + (row0 + r) * 1024 + p * 8;
    __builtin_amdgcn_global_load_lds((const unsigned*)src, (LAS unsigned*)(slot + wave * 1024), 16, 0, 0);
}
__device__ __forceinline__ void load_kfrag_lds(bf16x8 (&kf)[4], const LAS unsigned char* kt, int lane) {
    const int r = lane & 31, h = lane >> 5, f = (r >> 1) & 7;
#pragma unroll
    for (int ks = 0; ks < 4; ++ks) kf[ks] = *(const LAS bf16x8*)(kt + r * 128 + (((2 * ks + h) ^ f) * 16));
}
#define ATT_WAIT(n) asm volatile("s_waitcnt vmcnt(" #n ")" ::: "memory")
__device__ __forceinline__ void att_wait(int ahead) {
    if (ahead >= 2) ATT_WAIT(4); else if (ahead == 1) ATT_WAIT(2); else ATT_WAIT(0);
}
__device__ __forceinline__ void att_dma2(LAS unsigned char* slot, const bf16* Kp, const bf16* Vp, size_t row0, int wave, int lane) {
    att_dma(slot, Kp, Vp, row0, wave, lane); att_dma(slot + 8192, Kp, Vp, row0 + 32, wave, lane);
}
__device__ __forceinline__ void att_bar() { asm volatile("s_waitcnt lgkmcnt(0)" ::: "memory"); __builtin_amdgcn_s_barrier(); asm volatile("" ::: "memory"); }

__device__ __forceinline__ f32x16 qk_block(const LAS unsigned char* blk, const bf16x8 (&qf)[4], int lane) {
    bf16x8 kf[4]; load_kfrag_lds(kf, blk, lane);
    f32x16 s;
#pragma unroll
    for (int i = 0; i < 16; ++i) s[i] = 0.f;
#pragma unroll
    for (int ks = 0; ks < 4; ++ks) s = MFMA32(kf[ks], qf[ks], s);
    return s;
}
__device__ __forceinline__ bool sb_block(f32x16 s, const LAS unsigned char* blk, const bf16x8 (&tri)[2], f32x16 (&o)[2], float& c2, bool diag, int c, int h, int lane) {
    f32x16 L;
#pragma unroll
    for (int i = 0; i < 16; ++i) {
        const float z = s[i] * QSCALE;
        const float sp = fmaxf(z, 0.f) + flog2(1.f + fexp2(-fabsf(z)));
        const bool valid = !diag || ((i & 3) + 8 * (i >> 2) + 4 * h) < c;
        L[i] = valid ? -sp : 0.f;
        s[i] = valid ? z : -1e30f;
    }
    bf16x8 h0, l0, h1, l1;
    split8<0>(L, h0, l0); split8<1>(L, h1, l1);
    f32x16 suf;
#pragma unroll
    for (int i = 0; i < 16; ++i) suf[i] = 0.f;
    suf = MFMA32(tri[0], h0, suf); suf = MFMA32(tri[1], h1, suf); suf = MFMA32(tri[0], l0, suf); suf = MFMA32(tri[1], l1, suf);
#pragma unroll
    for (int i = 0; i < 16; ++i) s[i] = fexp2(s[i] + suf[i] + c2);
    pv_block(o, blk + 4096, pack8<0>(s), pack8<1>(s), lane);
    c2 += __shfl(suf[0], c);
    return __all(c2 < -64.f) != 0;
}
__device__ __forceinline__ void sb_wg_unit(int unit, LAS unsigned char* lds, const bf16* QK, const bf16* Vb, bf16* Osb, int wave, int lane) {
    const int qs = unit & 31, hd = (unit >> 5) & 7, b = unit >> 8;
    const int Q0 = qs * 256, q0 = Q0 + 32 * wave, c = lane & 31, h = lane >> 5;
    const size_t rowbase = (size_t)b * SEQ;
    const bf16* Kp = QK + 512 + hd * 64; const bf16* Vp = Vb + hd * 64;
    LAS unsigned* flags = (LAS unsigned*)(lds + ATT_FLAGS);
    bf16x8 qf[4];
    { const bf16* qp = QK + (rowbase + q0 + c) * 1024 + hd * 64 + 8 * h;
#pragma unroll
      for (int ks = 0; ks < 4; ++ks) qf[ks] = *(const bf16x8*)(qp + 16 * ks);
      asm volatile("" :: "v"(qf[0]), "v"(qf[1]), "v"(qf[2]), "v"(qf[3])); }
    att_bar();
    if (lane < 2) flags[lane * 8 + wave] = 0u;
    bf16x8 tri[2];
#pragma unroll
    for (int ks = 0; ks < 2; ++ks)
#pragma unroll
        for (int j = 0; j < 8; ++j) tri[ks][j] = (16 * ks + 8 * (j >> 2) + 4 * h + (j & 3) >= c) ? (short)0x3F80 : (short)0;
    f32x16 o[2];
#pragma unroll
    for (int i = 0; i < 16; ++i) { o[0][i] = 0.f; o[1][i] = 0.f; }
    float c2 = 0.f; bool mydone = false;
    const int Jmin = -(Q0 >> 6);
    att_bar();
    int slot = 0;
#pragma unroll
    for (int d = 0; d < 3; ++d) if (3 - d >= Jmin) att_dma2(lds + d * ATT_SLOT, Kp, Vp, rowbase + Q0 + 64 * (3 - d), wave, lane);
    for (int J = 3; J >= Jmin; --J) {
        att_wait(J - Jmin < 2 ? J - Jmin : 2);
        att_bar();
        const LAS unsigned* fr = flags + ((J + 1) & 1) * 8;
        const u32x4 f0 = *(const LAS u32x4*)fr, f1 = *(const LAS u32x4*)(fr + 4);
        if (J < 3 && (f0.x & f0.y & f0.z & f0.w & f1.x & f1.y & f1.z & f1.w) != 0u) break;
        const LAS unsigned char* img = lds + slot * ATT_SLOT;
        const int sprev = slot == 0 ? ATT_NSLOT - 1 : slot - 1;
        if (J - 3 >= Jmin) att_dma2(lds + sprev * ATT_SLOT, Kp, Vp, rowbase + Q0 + 64 * (J - 3), wave, lane);
        if (!mydone && 2 * J <= wave) {
            const bool hi_on = 2 * J + 1 <= wave;
            f32x16 s_hi, s_lo = qk_block(img, qf, lane);
            if (hi_on) { s_hi = qk_block(img + 8192, qf, lane); mydone = sb_block(s_hi, img + 8192, tri, o, c2, 2 * J + 1 == wave, c, h, lane); }
            if (!mydone) mydone = sb_block(s_lo, img, tri, o, c2, 2 * J == wave, c, h, lane);
        }
        if (lane == 0) flags[(J & 1) * 8 + wave] = mydone ? 1u : 0u;
        slot = slot + 1 == ATT_NSLOT ? 0 : slot + 1;
    }
    ATT_WAIT(0);
    store_ot(o, 1.f, Osb + (rowbase + q0 + c) * 1024 + hd * 64, h);
}
__device__ __forceinline__ void ca_block(f32x16 s, const LAS unsigned char* blk, f32x16 (&o)[2], float& m, float& l, const LAS float* bh, int key0, int q0, int c, int h, int lane) {
    const bool cbias = key0 <= q0 - 159;
    float bc = 0.f;
    if (cbias) bc = bh[128];
    else {
        const int relb = q0 + c - key0 - 4 * h;
#pragma unroll
        for (int i = 0; i < 16; ++i) { int rel = relb - ((i & 3) + 8 * (i >> 2)); rel = rel < -128 ? -128 : (rel > 128 ? 128 : rel); s[i] = s[i] + bh[rel] * (1.f / QSCALE); }
    }
    float bm = s[0];
#pragma unroll
    for (int i = 1; i < 16; ++i) bm = fmaxf(bm, s[i]);
    bm = fmaxf(bm, __shfl_xor(bm, 32)) * QSCALE + bc;
    const float mn = fmaxf(m, bm);
    if (__any(mn - m > 8.f)) {
        const float alpha = fexp2(m - mn); l *= alpha; m = mn;
#pragma unroll
        for (int i = 0; i < 16; ++i) { o[0][i] *= alpha; o[1][i] *= alpha; }
    }
    const float off = bc - m;
#pragma unroll
    for (int i = 0; i < 16; ++i) s[i] = fexp2(s[i] * QSCALE + off);
    const bf16x8 p0 = pack8<0>(s), p1 = pack8<1>(s);
    { const u32x4 a = __builtin_bit_cast(u32x4, p0), b = __builtin_bit_cast(u32x4, p1); float ps = 0.f;
      ps = dot2bf(a.x, 0x3F803F80u, ps); ps = dot2bf(a.y, 0x3F803F80u, ps); ps = dot2bf(a.z, 0x3F803F80u, ps); ps = dot2bf(a.w, 0x3F803F80u, ps);
      ps = dot2bf(b.x, 0x3F803F80u, ps); ps = dot2bf(b.y, 0x3F803F80u, ps); ps = dot2bf(b.z, 0x3F803F80u, ps); ps = dot2bf(b.w, 0x3F803F80u, ps);
      l += ps; }
    pv_block(o, blk + 4096, p0, p1, lane);
}
__device__ __forceinline__ void ca_wg_unit(int unit, LAS unsigned char* lds, const LAS float* biasl, const bf16* Qc, const bf16* KVc, bf16* Oca, int wave, int lane) {
    const int qs = unit & 31, hd = (unit >> 5) & 7, b = unit >> 8;
    const int Q0 = qs * 256, q0 = Q0 + 32 * wave, c = lane & 31, h = lane >> 5;
    const size_t rowbase = (size_t)b * SEQ;
    const bf16* Kp = KVc + hd * 64; const bf16* Vp = KVc + 512 + hd * 64;
    bf16x8 qf[4];
    { const bf16* qp = Qc + (rowbase + q0 + c) * 1024 + 512 + hd * 64 + 8 * h;
#pragma unroll
      for (int ks = 0; ks < 4; ++ks) qf[ks] = *(const bf16x8*)(qp + 16 * ks);
      asm volatile("" :: "v"(qf[0]), "v"(qf[1]), "v"(qf[2]), "v"(qf[3])); }
    const LAS float* bh = biasl + hd * 257 + 128;
    f32x16 o[2];
#pragma unroll
    for (int i = 0; i < 16; ++i) { o[0][i] = 0.f; o[1][i] = 0.f; }
    float m = -1e30f, l = 0.f;
    const int kb0 = (Q0 >= 512) ? 0 : (512 - Q0) / 64, wlo = wave >> 1;
    const long kbase = (long)rowbase + Q0 - 512;
    att_bar();
    int slot = 0;
#pragma unroll
    for (int d = 0; d < 3; ++d) att_dma2(lds + d * ATT_SLOT, Kp, Vp, (size_t)(kbase + 64 * (kb0 + d)), wave, lane);
    for (int kb = kb0; kb < 12; ++kb) {
        att_wait(11 - kb < 2 ? 11 - kb : 2);
        att_bar();
        const LAS unsigned char* img = lds + slot * ATT_SLOT;
        const int sprev = slot == 0 ? ATT_NSLOT - 1 : slot - 1;
        if (kb + 3 < 12) att_dma2(lds + sprev * ATT_SLOT, Kp, Vp, (size_t)(kbase + 64 * (kb + 3)), wave, lane);
        if (kb >= wlo && kb < wlo + 9) {
            const f32x16 sa = qk_block(img, qf, lane), sb = qk_block(img + 8192, qf, lane);
            ca_block(sa, img, o, m, l, bh, Q0 - 512 + 64 * kb, q0, c, h, lane);
            ca_block(sb, img + 8192, o, m, l, bh, Q0 - 512 + 64 * kb + 32, q0, c, h, lane);
        }
        slot = slot + 1 == ATT_NSLOT ? 0 : slot + 1;
    }
    l += __shfl_xor(l, 32);
    store_ot(o, 1.f / l, Oca + (rowbase + q0 + c) * 1024 + hd * 64, h);
}

#define CE(x, y) do { const float hi_ = fmaxf(x, y); y = fminf(x, y); x = hi_; } while (0)
#define SORT16(a) do { CE(a[0], a[1]); CE(a[2], a[3]); CE(a[0], a[2]); CE(a[1], a[3]); CE(a[1], a[2]); CE(a[4], a[5]); CE(a[6], a[7]); CE(a[4], a[6]); CE(a[5], a[7]); CE(a[5], a[6]); CE(a[0], a[4]); CE(a[2], a[6]); CE(a[2], a[4]); CE(a[1], a[5]); CE(a[3], a[7]); CE(a[3], a[5]); CE(a[1], a[2]); CE(a[3], a[4]); CE(a[5], a[6]); CE(a[8], a[9]); CE(a[10], a[11]); CE(a[8], a[10]); CE(a[9], a[11]); CE(a[9], a[10]); CE(a[12], a[13]); CE(a[14], a[15]); CE(a[12], a[14]); CE(a[13], a[15]); CE(a[13], a[14]); CE(a[8], a[12]); CE(a[10], a[14]); CE(a[10], a[12]); CE(a[9], a[13]); CE(a[11], a[15]); CE(a[11], a[13]); CE(a[9], a[10]); CE(a[11], a[12]); CE(a[13], a[14]); CE(a[0], a[8]); CE(a[4], a[12]); CE(a[4], a[8]); CE(a[2], a[10]); CE(a[6], a[14]); CE(a[6], a[10]); CE(a[2], a[4]); CE(a[6], a[8]); CE(a[10], a[12]); CE(a[1], a[9]); CE(a[5], a[13]); CE(a[5], a[9]); CE(a[3], a[11]); CE(a[7], a[15]); CE(a[7], a[11]); CE(a[3], a[5]); CE(a[7], a[9]); CE(a[11], a[13]); CE(a[1], a[2]); CE(a[3], a[4]); CE(a[5], a[6]); CE(a[7], a[8]); CE(a[9], a[10]); CE(a[11], a[12]); CE(a[13], a[14]); } while (0)
#define BMERGE16(a) do { CE(a[0], a[8]); CE(a[1], a[9]); CE(a[2], a[10]); CE(a[3], a[11]); CE(a[4], a[12]); CE(a[5], a[13]); CE(a[6], a[14]); CE(a[7], a[15]); CE(a[0], a[4]); CE(a[1], a[5]); CE(a[2], a[6]); CE(a[3], a[7]); CE(a[8], a[12]); CE(a[9], a[13]); CE(a[10], a[14]); CE(a[11], a[15]); CE(a[0], a[2]); CE(a[1], a[3]); CE(a[4], a[6]); CE(a[5], a[7]); CE(a[8], a[10]); CE(a[9], a[11]); CE(a[12], a[14]); CE(a[13], a[15]); CE(a[0], a[1]); CE(a[2], a[3]); CE(a[4], a[5]); CE(a[6], a[7]); CE(a[8], a[9]); CE(a[10], a[11]); CE(a[12], a[13]); CE(a[14], a[15]); } while (0)

__device__ __forceinline__ void keys16(float (&N)[16], const u32x4 a, const u32x4 b, int base) {
    const unsigned w[8] = {a.x, a.y, a.z, a.w, b.x, b.y, b.z, b.w};
#pragma unroll
    for (int i = 0; i < 8; ++i) { N[2 * i] = __uint_as_float((w[i] << 16) | (unsigned)(base + 2 * i)); N[2 * i + 1] = __uint_as_float((w[i] & 0xffff0000u) | (unsigned)(base + 2 * i + 1)); }
}
__device__ __forceinline__ void top16_of_128(float (&L)[16], const unsigned short* p) {
    u32x4 va[8], vb[8];
#pragma unroll
    for (int i = 0; i < 8; ++i) va[i] = *(const u32x4*)(p + 512 * i);
#pragma unroll
    for (int i = 0; i < 8; ++i) vb[i] = *(const u32x4*)(p + 512 * (8 + i));
    float N[16];
    keys16(L, va[0], va[1], 0); SORT16(L);
#pragma unroll
    for (int ch = 1; ch < 8; ++ch) {
        if (ch < 4) keys16(N, va[2 * ch], va[2 * ch + 1], 16 * ch); else keys16(N, vb[2 * ch - 8], vb[2 * ch - 7], 16 * ch);
        SORT16(N);
#pragma unroll
        for (int k = 0; k < 16; ++k) L[k] = fmaxf(L[k], N[15 - k]);
        BMERGE16(L);
    }
}
__device__ __forceinline__ float f16bits_to_f32(unsigned h) { return (float)__builtin_bit_cast(_Float16, (unsigned short)h); }
__device__ __forceinline__ void topk_task(int task, const unsigned short* scores, int* idx_out, float* g_out, LAS int* scr, int lane) {
    const int tb = task >> 3, h = task & 7; const int t = tb * 64 + lane;
    const unsigned short* sp = scores + (size_t)(tb * 8 + h) * (32 * 512) + lane * 8;
    float A[16], B[16];
    top16_of_128(A, sp);
    top16_of_128(B, sp + 16 * 512);
    float av[16], bv[16];
#pragma unroll
    for (int k = 0; k < 16; ++k) { const unsigned ua = __float_as_uint(A[k]), ub = __float_as_uint(B[k]);
        av[k] = f16bits_to_f32(ua >> 16); bv[k] = f16bits_to_f32(ub >> 16);
        scr[k * 64 + lane] = (int)(ua & 0x7fu) * 128; scr[(16 + k) * 64 + lane] = (int)(ub & 0x7fu); }
    const float NINF = -__builtin_inff();
    float lv[16];
#pragma unroll
    for (int k = 0; k < 16; ++k) lv[k] = NINF;
#pragma unroll
    for (int i = 0; i < 16; ++i)
#pragma unroll
        for (int j = 0; j < 16; ++j)
            if ((i + 1) * (j + 1) <= 16) {
                float x = __uint_as_float((__float_as_uint(av[i] + bv[j]) & 0xffffff00u) | (unsigned)(16 * i + j));
#pragma unroll
                for (int k = (i + 1) * (j + 1) - 1; k < 16; ++k) { const float hi = fmaxf(lv[k], x); x = fminf(lv[k], x); lv[k] = hi; }
            }
    float e[16]; int li[16]; float sum = 0.f;
    const float v0 = __uint_as_float(__float_as_uint(lv[0]) & 0xffffff00u);
#pragma unroll
    for (int k = 0; k < 16; ++k) { const unsigned u = __float_as_uint(lv[k]); const int ci = (u >> 4) & 15, cj = u & 15;
        li[k] = scr[ci * 64 + lane] + scr[(16 + cj) * 64 + lane];
        e[k] = fexp2((__uint_as_float(u & 0xffffff00u) - v0) * LOG2E); sum += e[k]; }
    const float inv = 1.f / sum;
    int* io = idx_out + (size_t)t * 128 + h * 16; float* go = g_out + (size_t)t * 128 + h * 16;
#pragma unroll
    for (int k = 0; k < 16; k += 4) { *(int4*)(io + k) = make_int4(li[k], li[k + 1], li[k + 2], li[k + 3]);
        *(f32x4*)(go + k) = (f32x4){e[k] * inv, e[k + 1] * inv, e[k + 2] * inv, e[k + 3] * inv}; }
}

constexpr int P7_NS = 4, P7_SLICE_BYTES = 16384 * 128, P7_WPS = 512;
__device__ __forceinline__ float wave_max(float v) {
#pragma unroll
    for (int o = 1; o < 64; o <<= 1) v = fmaxf(v, __shfl_xor(v, o));
    return v;
}
__device__ __forceinline__ unsigned pack8_fp4(const f32x4 a, const f32x4 b, float inv) {
    unsigned p = 0;
    p = __builtin_amdgcn_cvt_scalef32_pk_fp4_f32(p, a.x * inv, a.y * inv, 1.0f, 0); p = __builtin_amdgcn_cvt_scalef32_pk_fp4_f32(p, a.z * inv, a.w * inv, 1.0f, 1);
    p = __builtin_amdgcn_cvt_scalef32_pk_fp4_f32(p, b.x * inv, b.y * inv, 1.0f, 2); p = __builtin_amdgcn_cvt_scalef32_pk_fp4_f32(p, b.z * inv, b.w * inv, 1.0f, 3);
    return p;
}
__device__ __forceinline__ void fp8_row_load(f32x4 (&v)[4], const float* src, int lane) {
    const f32x4* sp = (const f32x4*)src + 4 * lane;
#pragma unroll
    for (int j = 0; j < 4; ++j) v[j] = sp[j];
}
__device__ __forceinline__ void fp8_row_finish(f32x4 (&v)[4], const float* colscale, unsigned char* dst, float* scale_out, int lane) {
    float am = 0.f;
#pragma unroll
    for (int j = 0; j < 4; ++j) { if (colscale) v[j] = v[j] * ((const f32x4*)colscale)[4 * lane + j];
        am = fmaxf(am, fmaxf(fmaxf(fabsf(v[j].x), fabsf(v[j].y)), fmaxf(fabsf(v[j].z), fabsf(v[j].w)))); }
    am = wave_max(am);
    const float sc = am > 0.f ? am * (1.f / 6.f) : 1.f, inv = 1.f / sc;
    u32x2 o; o.x = pack8_fp4(v[0], v[1], inv); o.y = pack8_fp4(v[2], v[3], inv);
    *(u32x2*)(dst + (size_t)(lane >> 4) * P7_SLICE_BYTES + 8 * (lane & 15)) = o;
    if (lane == 0) *scale_out = sc;
}
__device__ __forceinline__ unsigned pack8_i4(const f32x4 a, const f32x4 b, float inv) {
    const float MAGIC = 12582912.f;
    const unsigned n0 = __float_as_uint(a.x * inv + MAGIC) & 15u, n1 = __float_as_uint(a.y * inv + MAGIC) & 15u, n2 = __float_as_uint(a.z * inv + MAGIC) & 15u, n3 = __float_as_uint(a.w * inv + MAGIC) & 15u;
    const unsigned n4 = __float_as_uint(b.x * inv + MAGIC) & 15u, n5 = __float_as_uint(b.y * inv + MAGIC) & 15u, n6 = __float_as_uint(b.z * inv + MAGIC) & 15u, n7 = __float_as_uint(b.w * inv + MAGIC) & 15u;
    return (n0 | (n4 << 4)) | ((n1 | (n5 << 4)) << 8) | ((n2 | (n6 << 4)) << 16) | ((n3 | (n7 << 4)) << 24);
}
__device__ __forceinline__ void int4_row_finish(f32x4 (&v)[4], const float* colscale, unsigned char* dst, float* scale_out, int lane) {
    float am = 0.f;
#pragma unroll
    for (int j = 0; j < 4; ++j) { if (colscale) v[j] = v[j] * ((const f32x4*)colscale)[4 * lane + j];
        am = fmaxf(am, fmaxf(fmaxf(fabsf(v[j].x), fabsf(v[j].y)), fmaxf(fabsf(v[j].z), fabsf(v[j].w)))); }
    am = wave_max(am);
    const float sc = am > 0.f ? am * (1.f / 7.f) : 1.f, inv = 1.f / sc;
    u32x2 o; o.x = pack8_i4(v[0], v[1], inv); o.y = pack8_i4(v[2], v[3], inv);
    *(u32x2*)(dst + (size_t)(lane >> 4) * P7_SLICE_BYTES + 8 * (lane & 15)) = o;
    if (lane == 0) *scale_out = sc;
}
#define FP4PAIR(w, sel) __builtin_amdgcn_cvt_scalef32_pk_f32_fp4((w), 1.0f, (sel))
__device__ __forceinline__ float dot32_fp4(const u32x4 r, const f32x2 (&h)[16]) {
    f32x2 s0 = FP4PAIR(r.x, 0) * h[0], s1 = FP4PAIR(r.x, 1) * h[1];
    s0 = __builtin_elementwise_fma(FP4PAIR(r.x, 2), h[2], s0); s1 = __builtin_elementwise_fma(FP4PAIR(r.x, 3), h[3], s1);
    s0 = __builtin_elementwise_fma(FP4PAIR(r.y, 0), h[4], s0); s1 = __builtin_elementwise_fma(FP4PAIR(r.y, 1), h[5], s1);
    s0 = __builtin_elementwise_fma(FP4PAIR(r.y, 2), h[6], s0); s1 = __builtin_elementwise_fma(FP4PAIR(r.y, 3), h[7], s1);
    s0 = __builtin_elementwise_fma(FP4PAIR(r.z, 0), h[8], s0); s1 = __builtin_elementwise_fma(FP4PAIR(r.z, 1), h[9], s1);
    s0 = __builtin_elementwise_fma(FP4PAIR(r.z, 2), h[10], s0); s1 = __builtin_elementwise_fma(FP4PAIR(r.z, 3), h[11], s1);
    s0 = __builtin_elementwise_fma(FP4PAIR(r.w, 0), h[12], s0); s1 = __builtin_elementwise_fma(FP4PAIR(r.w, 1), h[13], s1);
    s0 = __builtin_elementwise_fma(FP4PAIR(r.w, 2), h[14], s0); s1 = __builtin_elementwise_fma(FP4PAIR(r.w, 3), h[15], s1);
    s0 = s0 + s1;
    return s0.x + s0.y;
}
__device__ __forceinline__ void axpy32_fp4(f32x2 (&o)[16], float c, const u32x4 r) {
    const f32x2 cc = (f32x2){c, c};
    o[0] = __builtin_elementwise_fma(cc, FP4PAIR(r.x, 0), o[0]); o[1] = __builtin_elementwise_fma(cc, FP4PAIR(r.x, 1), o[1]); o[2] = __builtin_elementwise_fma(cc, FP4PAIR(r.x, 2), o[2]); o[3] = __builtin_elementwise_fma(cc, FP4PAIR(r.x, 3), o[3]);
    o[4] = __builtin_elementwise_fma(cc, FP4PAIR(r.y, 0), o[4]); o[5] = __builtin_elementwise_fma(cc, FP4PAIR(r.y, 1), o[5]); o[6] = __builtin_elementwise_fma(cc, FP4PAIR(r.y, 2), o[6]); o[7] = __builtin_elementwise_fma(cc, FP4PAIR(r.y, 3), o[7]);
    o[8] = __builtin_elementwise_fma(cc, FP4PAIR(r.z, 0), o[8]); o[9] = __builtin_elementwise_fma(cc, FP4PAIR(r.z, 1), o[9]); o[10] = __builtin_elementwise_fma(cc, FP4PAIR(r.z, 2), o[10]); o[11] = __builtin_elementwise_fma(cc, FP4PAIR(r.z, 3), o[11]);
    o[12] = __builtin_elementwise_fma(cc, FP4PAIR(r.w, 0), o[12]); o[13] = __builtin_elementwise_fma(cc, FP4PAIR(r.w, 1), o[13]); o[14] = __builtin_elementwise_fma(cc, FP4PAIR(r.w, 2), o[14]); o[15] = __builtin_elementwise_fma(cc, FP4PAIR(r.w, 3), o[15]);
}
__device__ __forceinline__ float swap_add32(float x, float y) { const auto r = __builtin_amdgcn_permlane32_swap(__float_as_uint(x), __float_as_uint(y), false, false); return __uint_as_float(r[0]) + __uint_as_float(r[1]); }
__device__ __forceinline__ float swap_add16(float x, float y) { const auto r = __builtin_amdgcn_permlane16_swap(__float_as_uint(x), __float_as_uint(y), false, false); return __uint_as_float(r[0]) + __uint_as_float(r[1]); }
__device__ __forceinline__ float dpp_ror8(float v) { return __int_as_float(__builtin_amdgcn_mov_dpp(__float_as_int(v), 0x128, 0xf, 0xf, true)); }
__device__ __forceinline__ void reduce32x8(const float (&d)[32], int lane, float (&r)[4]) {
    const bool b3 = (lane & 8) != 0;
    float k16[16], k8[8];
#pragma unroll
    for (int i = 0; i < 16; ++i) k16[i] = swap_add32(d[i], d[16 + i]);
#pragma unroll
    for (int i = 0; i < 8; ++i) k8[i] = swap_add16(k16[i], k16[8 + i]);
#pragma unroll
    for (int i = 0; i < 4; ++i) { const float keep = b3 ? k8[4 + i] : k8[i], send = b3 ? k8[i] : k8[4 + i]; r[i] = keep + dpp_ror8(send); }
}
__device__ __forceinline__ constexpr int rev3(int e) { return ((e & 1) << 2) | (e & 2) | ((e >> 2) & 1); }
__device__ __forceinline__ float reduce8x8(const float (&d)[8], int lane) {
    const bool b0 = (lane & 1) != 0, b1 = (lane & 2) != 0, b2 = (lane & 4) != 0;
    float k4[4], k2[2];
#pragma unroll
    for (int i = 0; i < 4; ++i) { const float keep = b0 ? d[4 + i] : d[i], send = b0 ? d[i] : d[4 + i]; k4[i] = keep + __shfl_xor(send, 1); }
#pragma unroll
    for (int i = 0; i < 2; ++i) { const float keep = b1 ? k4[2 + i] : k4[i], send = b1 ? k4[i] : k4[2 + i]; k2[i] = keep + __shfl_xor(send, 2); }
    const float keep = b2 ? k2[1] : k2[0], send = b2 ? k2[0] : k2[1];
    return keep + __shfl_xor(send, 4);
}
__device__ __forceinline__ void p7_load_idx(int (&ex)[8], const int* idx, int t, int half, int e8) {
    const int4* p = (const int4*)(idx + (size_t)t * 128 + 16 * e8 + 8 * half);
    const int4 v0 = p[0], v1 = p[1];
    ex[0] = v0.x; ex[1] = v0.y; ex[2] = v0.z; ex[3] = v0.w; ex[4] = v1.x; ex[5] = v1.y; ex[6] = v1.z; ex[7] = v1.w;
}
__device__ __forceinline__ void p7_issue_rows(u32x4 (&r)[8], const unsigned char* tab, const int (&ex)[8], int boff) {
#pragma unroll
    for (int j = 0; j < 8; ++j) r[j] = *(const u32x4*)(tab + (unsigned)((ex[j] << 7) + boff));
}
template <int CTRL> __device__ __forceinline__ int dpp_i(int v) { return __builtin_amdgcn_mov_dpp(v, CTRL, 0xf, 0xf, true); }
template <int CTRL> __device__ __forceinline__ float dpp_f(float v) { return __int_as_float(__builtin_amdgcn_mov_dpp(__float_as_int(v), CTRL, 0xf, 0xf, true)); }
struct P7aState { unsigned ix[4]; u32x4 r[2][8]; u32x2 x; };
struct P7aX { unsigned hn[4], ln[4]; float sx; };
struct P7aLaneK { unsigned sh_h, mask_h, sh_l, mask_l, xor_l; };
__device__ __forceinline__ float wave_max_fast(float v) {
    v = fmaxf(v, dpp_f<0xB1>(v)); v = fmaxf(v, dpp_f<0x4E>(v)); v = fmaxf(v, dpp_f<0x141>(v)); v = fmaxf(v, dpp_f<0x140>(v));
    { const auto r = __builtin_amdgcn_permlane16_swap(__float_as_uint(v), __float_as_uint(v), false, false); v = fmaxf(__uint_as_float(r[0]), __uint_as_float(r[1])); }
    { const auto r = __builtin_amdgcn_permlane32_swap(__float_as_uint(v), __float_as_uint(v), false, false); v = fmaxf(__uint_as_float(r[0]), __uint_as_float(r[1])); }
    return v;
}
__device__ __forceinline__ void p7a_quant_x(P7aX& q, const u32x2 x, const P7aLaneK& k, LAS unsigned* xb, int lane) {
    const float f0 = bf_lo(x.x), f1 = bf_hi(x.x), f2 = bf_lo(x.y), f3 = bf_hi(x.y);
    const float am = wave_max_fast(fmaxf(fmaxf(fabsf(f0), fabsf(f1)), fmaxf(fabsf(f2), fabsf(f3))));
    const float sx = am > 0.f ? am * (1.f / 119.f) : 1.f, inv = __builtin_amdgcn_rcpf(sx), MAGIC8 = 12582912.f + 8.f;
    const unsigned b0 = __float_as_uint(f0 * inv + MAGIC8), b1 = __float_as_uint(f1 * inv + MAGIC8), b2 = __float_as_uint(f2 * inv + MAGIC8), b3 = __float_as_uint(f3 * inv + MAGIC8);
    const unsigned P = __builtin_amdgcn_perm(b1, b0, 0x0c0c0400u) | __builtin_amdgcn_perm(b3, b2, 0x04000c0cu);
    const unsigned hp = (P >> k.sh_h) & k.mask_h;
    const unsigned lp = ((P << k.sh_l) & k.mask_l) ^ k.xor_l;
    const unsigned hn = hp | (unsigned)dpp_i<0xB1>((int)hp), ln = lp | (unsigned)dpp_i<0xB1>((int)lp);
    xb[lane >> 1] = hn; xb[32 + (lane >> 1)] = ln;
    const u32x4 h = *(const LAS u32x4*)(xb + 4 * (lane & 7)), l = *(const LAS u32x4*)(xb + 32 + 4 * (lane & 7));
    q.hn[0] = h.x; q.hn[1] = h.y; q.hn[2] = h.z; q.hn[3] = h.w; q.ln[0] = l.x; q.ln[1] = l.y; q.ln[2] = l.z; q.ln[3] = l.w;
    q.sx = sx;
}
__device__ __forceinline__ int dot8z(unsigned a, unsigned b) { int d; asm("v_dot8_i32_i4 %0, %1, %2, 0" : "=v"(d) : "v"(a), "v"(b)); return d; }
__device__ __forceinline__ int dot32_i4(const u32x4 r, const P7aX& q) {
    int dh = dot8z(r.x, q.hn[0]), dl = dot8z(r.x, q.ln[0]);
    dh = __builtin_amdgcn_sdot8((int)r.y, (int)q.hn[1], dh, false); dl = __builtin_amdgcn_sdot8((int)r.y, (int)q.ln[1], dl, false);
    dh = __builtin_amdgcn_sdot8((int)r.z, (int)q.hn[2], dh, false); dl = __builtin_amdgcn_sdot8((int)r.z, (int)q.ln[2], dl, false);
    dh = __builtin_amdgcn_sdot8((int)r.w, (int)q.hn[3], dh, false); dl = __builtin_amdgcn_sdot8((int)r.w, (int)q.ln[3], dl, false);
    return (dh << 4) + dl;
}
__device__ __forceinline__ int red8_index(int lane) { return (lane & 4) | ((lane & 1) << 1) | ((lane >> 1) & 1); }
__device__ __forceinline__ int reduce8x8i(const int (&d)[8], int lane) {
    const bool b2 = (lane & 4) != 0, b0 = (lane & 1) != 0, b1 = (lane & 2) != 0;
    int k4[4], k2[2];
#pragma unroll
    for (int i = 0; i < 4; ++i) { const int keep = b2 ? d[4 + i] : d[i], send = b2 ? d[i] : d[4 + i]; k4[i] = keep + dpp_i<0x141>(send); }
#pragma unroll
    for (int i = 0; i < 2; ++i) { const int keep = b0 ? k4[2 + i] : k4[i], send = b0 ? k4[i] : k4[2 + i]; k2[i] = keep + dpp_i<0xB1>(send); }
    const int keep = b1 ? k2[1] : k2[0], send = b1 ? k2[0] : k2[1];
    return keep + dpp_i<0x4E>(send);
}
__device__ __forceinline__ void p7a_compute(const u32x4 (&r)[8], const P7aX& q, _Float16* pd_t, int half, int e8, int lane) {
    int d[8];
#pragma unroll
    for (int j = 0; j < 8; ++j) d[j] = dot32_i4(r[j], q);
    const int tot = reduce8x8i(d, lane);
    pd_t[16 * e8 + 8 * half + red8_index(lane)] = (_Float16)((float)tot * q.sx);
}
__device__ __forceinline__ void p7a_issue_rows(u32x4 (&r)[8], const unsigned char* tab, const LAS unsigned* ib, int e8, int boff) {
    const u32x4 o0 = *(const LAS u32x4*)(ib + 8 * e8), o1 = *(const LAS u32x4*)(ib + 8 * e8 + 4);
    const unsigned off[8] = {o0.x + boff, o0.y + boff, o0.z + boff, o0.w + boff, o1.x + boff, o1.y + boff, o1.z + boff, o1.w + boff};
    asm volatile("s_nop 4\n\tglobal_load_dwordx4 %0, %1, %2 ; P7A_LD" : "=v"(r[0]) : "v"(off[0]), "s"(tab) : "memory");
#pragma unroll
    for (int j = 1; j < 8; ++j) asm volatile("global_load_dwordx4 %0, %1, %2 ; P7A_LD" : "=v"(r[j]) : "v"(off[j]), "s"(tab) : "memory");
}
__device__ __forceinline__ void p7a_issue_idx(unsigned& ix, const int* idx, int t, int half, int lane) {
    const unsigned off = (unsigned)(t * 128 + 16 * (lane >> 3) + 8 * half + (lane & 7)) * 4u;
    asm volatile("s_nop 4\n\tglobal_load_dword %0, %1, %2 ; P7A_LD" : "=v"(ix) : "v"(off), "s"(idx) : "memory");
}
__device__ __forceinline__ void p7a_issue_x(u32x2& x, const bf16* x1b_slice, int t, int lane) {
    const unsigned off = (unsigned)t * 2048u + 8u * (unsigned)lane;
    asm volatile("s_nop 4\n\tglobal_load_dwordx2 %0, %1, %2 ; P7A_LD" : "=v"(x) : "v"(off), "s"(x1b_slice) : "memory");
}
#define P7A_WAIT_ODD(n, r, e) asm volatile("s_waitcnt vmcnt(" #n ") ; P7A_WAIT" : "+v"((r)[0]), "+v"((r)[1]), "+v"((r)[2]), "+v"((r)[3]), "+v"((r)[4]), "+v"((r)[5]), "+v"((r)[6]), "+v"((r)[7]), "+v"(e) :: "memory")
#define P7A_WAIT_EVEN(n, r, e, x) asm volatile("s_waitcnt vmcnt(" #n ") ; P7A_WAIT" : "+v"((r)[0]), "+v"((r)[1]), "+v"((r)[2]), "+v"((r)[3]), "+v"((r)[4]), "+v"((r)[5]), "+v"((r)[6]), "+v"((r)[7]), "+v"(e), "+v"(x) :: "memory")
template <int S> __device__ __forceinline__ void p7a_step(P7aState& st, int tb, int tlast, const bf16* x1b, const unsigned char* U4, const int* idx, _Float16* pd, int e8, int boff, int lane, P7aX& q,
                                                          const P7aLaneK& lk, LAS unsigned* xb) {
    LAS unsigned* ib = xb + 64;
    p7a_issue_rows(st.r[(S + 1) & 1], U4, ib + 64 * ((S + 1) & 1), e8, boff);
    { int tk = tb + P7_WPS * ((S + 5) >> 1); tk = tk < tlast ? tk : tlast; p7a_issue_idx(st.ix[(S + 1) & 3], idx, tk, (S + 5) & 1, lane); }
    const int t = tb + P7_WPS * (S >> 1);
    if ((S & 1) == 0) {
        P7A_WAIT_EVEN(10, st.r[S & 1], st.ix[(S + 2) & 3], st.x);
        ib[64 * (S & 1) + lane] = st.ix[(S + 2) & 3] << 7;
        p7a_quant_x(q, st.x, lk, xb, lane);
        int tk = t + P7_WPS; tk = tk < tlast ? tk : tlast;
        p7a_issue_x(st.x, x1b, tk, lane);
    } else {
        P7A_WAIT_ODD(11, st.r[S & 1], st.ix[(S + 2) & 3]);
        ib[64 * (S & 1) + lane] = st.ix[(S + 2) & 3] << 7;
    }
    p7a_compute(st.r[S & 1], q, pd + (size_t)t * 128, S & 1, e8, lane);
}
__device__ __forceinline__ void p7a_phase(int slice, int wrank, const bf16* x1b, const unsigned char* U4, const int* idx, _Float16* PD, int lane, LAS unsigned* xb) {
    const int e8 = lane >> 3, boff = 16 * (lane & 7);
    _Float16* pd = PD + (size_t)slice * T * 128;
    const int tlast = wrank + P7_WPS * 63;
    U4 += (size_t)slice * P7_SLICE_BYTES; x1b += 256 * slice;
    const bool odd = (lane & 1) != 0;
    const P7aLaneK lk = {odd ? 0u : 4u, odd ? 0xf0f0f0f0u : 0x0f0f0f0fu, odd ? 4u : 0u, odd ? 0xf0f0f0f0u : 0x0f0f0f0fu, odd ? 0x80808080u : 0x08080808u};
    LAS unsigned* ib = xb + 64;
    P7aState st; P7aX q;
    p7a_issue_idx(st.ix[0], idx, wrank, 0, lane); p7a_issue_idx(st.ix[1], idx, wrank, 1, lane); p7a_issue_idx(st.ix[2], idx, wrank + P7_WPS, 0, lane); p7a_issue_idx(st.ix[3], idx, wrank + P7_WPS, 1, lane);
    p7a_issue_x(st.x, x1b, wrank, lane);
    asm volatile("s_waitcnt vmcnt(0) ; P7A_WAIT" : "+v"(st.ix[0]), "+v"(st.ix[1]), "+v"(st.ix[2]), "+v"(st.ix[3]), "+v"(st.x) :: "memory");
    ib[lane] = st.ix[0] << 7; ib[64 + lane] = st.ix[1] << 7;
    p7a_issue_rows(st.r[0], U4, ib, e8, boff);
    p7a_issue_idx(st.ix[0], idx, wrank + 2 * P7_WPS, 0, lane);
#pragma unroll 1
    for (int it = 0; it < 16; ++it) {
        const int tb = wrank + 4 * P7_WPS * it;
        p7a_step<0>(st, tb, tlast, x1b, U4, idx, pd, e8, boff, lane, q, lk, xb); p7a_step<1>(st, tb, tlast, x1b, U4, idx, pd, e8, boff, lane, q, lk, xb);
        p7a_step<2>(st, tb, tlast, x1b, U4, idx, pd, e8, boff, lane, q, lk, xb); p7a_step<3>(st, tb, tlast, x1b, U4, idx, pd, e8, boff, lane, q, lk, xb);
        p7a_step<4>(st, tb, tlast, x1b, U4, idx, pd, e8, boff, lane, q, lk, xb); p7a_step<5>(st, tb, tlast, x1b, U4, idx, pd, e8, boff, lane, q, lk, xb);
        p7a_step<6>(st, tb, tlast, x1b, U4, idx, pd, e8, boff, lane, q, lk, xb); p7a_step<7>(st, tb, tlast, x1b, U4, idx, pd, e8, boff, lane, q, lk, xb);
    }
    asm volatile("s_waitcnt vmcnt(0) ; P7A_WAIT" : "+v"(st.r[0][0]), "+v"(st.r[0][1]), "+v"(st.r[0][2]), "+v"(st.r[0][3]), "+v"(st.r[0][4]), "+v"(st.r[0][5]), "+v"(st.r[0][6]), "+v"(st.r[0][7]),
                 "+v"(st.ix[0]), "+v"(st.ix[1]), "+v"(st.ix[2]), "+v"(st.ix[3]), "+v"(st.x) :: "memory");
}
struct P7bIn { float s0, s1, g0, g1, rs; int e0, e1; };
__device__ __forceinline__ void p7b_load(P7bIn& in, int t, const _Float16* PD, const int* idx, const float* gw, const float* rstd, int lane) {
    float s0 = 0.f, s1 = 0.f;
#pragma unroll
    for (int sl = 0; sl < P7_NS; ++sl) { const _Float16* p = PD + ((size_t)sl * T + t) * 128; s0 += (float)p[lane]; s1 += (float)p[lane + 64]; }
    in.s0 = s0; in.s1 = s1; in.e0 = idx[(size_t)t * 128 + lane]; in.e1 = idx[(size_t)t * 128 + 64 + lane];
    in.g0 = gw[(size_t)t * 128 + lane]; in.g1 = gw[(size_t)t * 128 + 64 + lane]; in.rs = rstd[t];
}
__device__ __forceinline__ void p7b_finish(const P7bIn& in, float su0, float su1, float sv0, float sv1, int t, float* gw, int lane) {
    const float z0 = in.s0 * su0 * in.rs, z1 = in.s1 * su1 * in.rs;
    const float a0 = 0.5f * z0 * (1.f + erff(z0 * 0.70710678118654752f)), a1 = 0.5f * z1 * (1.f + erff(z1 * 0.70710678118654752f));
    float* g = gw + (size_t)t * 128;
    g[lane] = in.g0 * sv0 * a0; g[lane + 64] = in.g1 * sv1 * a1;
}
__device__ __forceinline__ void p7b_phase(int gw_, int NGW, const _Float16* PD, const int* idx, float* gw, const float* SU, const float* SV, const float* rstd, int lane, LAS float* sl, int tid) {
    { const f32x4* s4 = (const f32x4*)SU; const f32x4* v4 = (const f32x4*)SV; LAS f32x4* l4 = (LAS f32x4*)sl;
#pragma unroll 4
      for (int i = tid; i < 4096; i += NTHREADS) { l4[i] = s4[i]; l4[4096 + i] = v4[i]; } }
    __syncthreads();
    const LAS float* SUl = sl; const LAS float* SVl = sl + 16384;
    P7bIn cur, nxt;
    p7b_load(cur, gw_, PD, idx, gw, rstd, lane);
    for (int t = gw_; t < T; t += NGW) {
        const int tn = t + NGW < T ? t + NGW : t;
        const float su0 = SUl[cur.e0], su1 = SUl[cur.e1], sv0 = SVl[cur.e0], sv1 = SVl[cur.e1];
        p7b_load(nxt, tn, PD, idx, gw, rstd, lane);
        p7b_finish(cur, su0, su1, sv0, sv1, t, gw, lane);
        cur = nxt;
    }
}
__device__ __forceinline__ void p7_load_cf(float (&cf)[8], const float* gw, int t, int half, int e8) {
    const f32x4* p = (const f32x4*)(gw + (size_t)t * 128 + 16 * e8 + 8 * half);
    const f32x4 v0 = p[0], v1 = p[1];
    cf[0] = v0.x; cf[1] = v0.y; cf[2] = v0.z; cf[3] = v0.w; cf[4] = v1.x; cf[5] = v1.y; cf[6] = v1.z; cf[7] = v1.w;
}
__device__ __forceinline__ void p7c_finish(const f32x2 (&acc2)[16], const bf16* x1b_t, bf16* x2b_t, float* ssq2_t, int col0, int lane) {
    float acc[32];
#pragma unroll
    for (int k = 0; k < 16; ++k) { acc[2 * k] = acc2[k].x; acc[2 * k + 1] = acc2[k].y; }
    float r[4]; reduce32x8(acc, lane, r);
    const int ib = 4 * (lane >> 3);
    const u32x2 xv = *(const u32x2*)(x1b_t + col0 + ib);
    const float y0 = bf_lo(xv.x) + r[0], y1 = bf_hi(xv.x) + r[1], y2 = bf_lo(xv.y) + r[2], y3 = bf_hi(xv.y) + r[3];
    u32x2 w; w.x = pk2(y0, y1); w.y = pk2(y2, y3);
    *(u32x2*)(x2b_t + col0 + ib) = w;
    const float ss = wave_sum((y0 * y0 + y1 * y1) + (y2 * y2 + y3 * y3));
    if (lane == 0) *ssq2_t = ss;
}
struct P7cState { int ex[4][8]; u32x4 r[2][8]; float cf[4][8]; };
template <int S> __device__ __forceinline__ void p7c_step(P7cState& st, int tb, int tlast, const bf16* x1b, bf16* xio, const unsigned char* V4, const int* idx, const float* gw, float* sq, int e8, int boff, int lane, f32x2 (&acc)[16]) {
    p7_issue_rows(st.r[(S + 1) & 1], V4, st.ex[(S + 1) & 3], boff);
    { int tk = tb + P7_WPS * ((S + 5) >> 1); tk = tk < tlast ? tk : tlast; p7_load_idx(st.ex[(S + 1) & 3], idx, tk, (S + 5) & 1, e8); }
    const int t = tb + P7_WPS * (S >> 1);
    if ((S & 1) == 0) {
#pragma unroll
        for (int k = 0; k < 16; ++k) acc[k] = (f32x2){0.f, 0.f};
    }
#pragma unroll
    for (int j = 0; j < 8; ++j) axpy32_fp4(acc, st.cf[S & 3][j], st.r[S & 1][j]);
    { int tk = tb + P7_WPS * ((S + 4) >> 1); tk = tk < tlast ? tk : tlast; p7_load_cf(st.cf[S & 3], gw, tk, S & 1, e8); }
    if ((S & 1) == 1) p7c_finish(acc, x1b + (size_t)t * 1024, xio + (size_t)t * 1024, sq + t, 2 * boff, lane);
}
__device__ __forceinline__ void p7c_phase(int slice, int wrank, const bf16* x1b, bf16* xio, const unsigned char* V4, const int* idx, const float* gw, float* SSQ2, int lane) {
    const int e8 = lane >> 3, boff = 16 * (lane & 7);
    float* sq = SSQ2 + (size_t)slice * T;
    const int tlast = wrank + P7_WPS * 63;
    V4 += (size_t)slice * P7_SLICE_BYTES; xio += 256 * slice; x1b += 256 * slice;
    P7cState st; f32x2 acc[16];
    p7_load_idx(st.ex[0], idx, wrank, 0, e8); p7_load_idx(st.ex[1], idx, wrank, 1, e8); p7_load_idx(st.ex[2], idx, wrank + P7_WPS, 0, e8); p7_load_idx(st.ex[3], idx, wrank + P7_WPS, 1, e8);
    p7_load_cf(st.cf[0], gw, wrank, 0, e8); p7_load_cf(st.cf[1], gw, wrank, 1, e8); p7_load_cf(st.cf[2], gw, wrank + P7_WPS, 0, e8); p7_load_cf(st.cf[3], gw, wrank + P7_WPS, 1, e8);
    p7_issue_rows(st.r[0], V4, st.ex[0], boff);
    p7_load_idx(st.ex[0], idx, wrank + 2 * P7_WPS, 0, e8);
#pragma unroll 1
    for (int it = 0; it < 16; ++it) {
        const int tb = wrank + 4 * P7_WPS * it;
        p7c_step<0>(st, tb, tlast, x1b, xio, V4, idx, gw, sq, e8, boff, lane, acc); p7c_step<1>(st, tb, tlast, x1b, xio, V4, idx, gw, sq, e8, boff, lane, acc);
        p7c_step<2>(st, tb, tlast, x1b, xio, V4, idx, gw, sq, e8, boff, lane, acc); p7c_step<3>(st, tb, tlast, x1b, xio, V4, idx, gw, sq, e8, boff, lane, acc);
        p7c_step<4>(st, tb, tlast, x1b, xio, V4, idx, gw, sq, e8, boff, lane, acc); p7c_step<5>(st, tb, tlast, x1b, xio, V4, idx, gw, sq, e8, boff, lane, acc);
        p7c_step<6>(st, tb, tlast, x1b, xio, V4, idx, gw, sq, e8, boff, lane, acc); p7c_step<7>(st, tb, tlast, x1b, xio, V4, idx, gw, sq, e8, boff, lane, acc);
    }
}
__device__ __forceinline__ void p7d_phase(int gw_, int NGW, const bf16* x2b, float* out, const float* SSQ2, const float* nf, int lane) {
    f32x4 g[4];
#pragma unroll
    for (int j = 0; j < 4; ++j) g[j] = ((const f32x4*)nf)[lane + 64 * j];
    u32x2 v[4], vn[4]; float s, sn;
    { const u32x2* xr = (const u32x2*)(x2b + (size_t)gw_ * 1024) + lane;
#pragma unroll
      for (int j = 0; j < 4; ++j) v[j] = xr[64 * j];
      s = 0.f;
#pragma unroll
      for (int sl = 0; sl < P7_NS; ++sl) s += SSQ2[(size_t)sl * T + gw_]; }
    for (int t = gw_; t < T; t += NGW) {
        const int tn = t + NGW < T ? t + NGW : t;
        { const u32x2* xr = (const u32x2*)(x2b + (size_t)tn * 1024) + lane;
#pragma unroll
          for (int j = 0; j < 4; ++j) vn[j] = xr[64 * j];
          sn = 0.f;
#pragma unroll
          for (int sl = 0; sl < P7_NS; ++sl) sn += SSQ2[(size_t)sl * T + tn]; }
        const float r2 = rsqrtf(s * (1.f / D) + RMS_EPS);
        f32x4* yr = (f32x4*)(out + (size_t)t * 1024) + lane;
#pragma unroll
        for (int j = 0; j < 4; ++j) yr[64 * j] = (f32x4){bf_lo(v[j].x) * r2 * g[j].x, bf_hi(v[j].x) * r2 * g[j].y, bf_lo(v[j].y) * r2 * g[j].z, bf_hi(v[j].y) * r2 * g[j].w};
#pragma unroll
        for (int j = 0; j < 4; ++j) v[j] = vn[j];
        s = sn;
    }
}

#define XB_TMO      128
#define XB_XCNT(j)  (256  + 64 * (j))
#define XB_XSUB(j)  (1280 + 64 * (j))
#define XB_XGEN(j)  (2304 + 64 * (j))
#define XB_TOP      3328
#define XB_TOPGEN   3392
#define XCD_BAR_WORDS 3456
#define XB_SPIN_CAP (1u << 18)

__device__ __forceinline__ unsigned xb_ld(unsigned* p)              { return __hip_atomic_load(p, __ATOMIC_RELAXED, __HIP_MEMORY_SCOPE_AGENT); }
__device__ __forceinline__ unsigned xb_add(unsigned* p, unsigned v) { return __hip_atomic_fetch_add(p, v, __ATOMIC_RELAXED, __HIP_MEMORY_SCOPE_AGENT); }
__device__ __forceinline__ unsigned xb_xcc_id() { return (unsigned)__builtin_amdgcn_s_getreg((3 << 11) | 20) & 0xFu; }
#define XB_SPIN(cond, bar) do { unsigned _sp = 0; while (cond) { __builtin_amdgcn_s_sleep(1); \
    if ((++_sp & 255u) == 0u) { if (xb_ld(&(bar)[XB_TMO])) break; if (_sp > XB_SPIN_CAP) { atomicAdd(&(bar)[XB_TMO], 1u); break; } } } } while (0)

struct XcdBarrier {
    unsigned* bar; unsigned x;
    volatile LAS unsigned* st;
};

__device__ __forceinline__ XcdBarrier xcd_barrier_post(unsigned* bar, volatile LAS unsigned* st) {
    XcdBarrier b; b.bar = bar; b.x = xb_xcc_id(); b.st = st;
    if (threadIdx.x == 0) (void)xb_add(&bar[XB_XCNT(b.x)], 1u);
    return b;
}
__device__ __forceinline__ void xcd_barrier_complete(unsigned* bar, unsigned x, unsigned& nloc, unsigned& nx) {
    const unsigned G = gridDim.x * gridDim.y * gridDim.z;
    unsigned sum, cnt, mine, sp = 0u;
    for (;;) {
        sum = 0u; cnt = 0u; mine = 0u;
#pragma unroll
        for (unsigned j = 0; j < 16; ++j) { const unsigned c = xb_ld(&bar[XB_XCNT(j)]); sum += c; cnt += (c > 0u) ? 1u : 0u; mine = (j == x) ? c : mine; }
        if (sum == G) break;
        __builtin_amdgcn_s_sleep(1);
        if ((++sp & 255u) == 0u) { if (xb_ld(&bar[XB_TMO])) break; if (sp > XB_SPIN_CAP) { atomicAdd(&bar[XB_TMO], 1u); break; } }
    }
    nloc = mine > 0u ? mine : 1u; nx = cnt > 0u ? cnt : 1u;
}

__device__ __forceinline__ void xcd_barrier(const XcdBarrier& b) {
    asm volatile("s_waitcnt vmcnt(0)" ::: "memory");
    __syncthreads();
    if (threadIdx.x == 0) {
        unsigned* bar = b.bar;
        __builtin_amdgcn_s_waitcnt(0);
        unsigned nloc = b.st[0], nx = b.st[1];
        if (nloc == 0u) { xcd_barrier_complete(bar, b.x, nloc, nx); b.st[0] = nloc; b.st[1] = nx; }
        const unsigned old = xb_add(&bar[XB_XSUB(b.x)], 1u);
        const unsigned gen = old / nloc;
        if (old + 1u == (gen + 1u) * nloc) {
            __builtin_amdgcn_fence(__ATOMIC_RELEASE, "agent");
            asm volatile("s_waitcnt vmcnt(0)" ::: "memory");
            const unsigned og = xb_add(&bar[XB_TOP], 1u);
            const unsigned tg = og / nx;
            if (og + 1u == (tg + 1u) * nx) xb_add(&bar[XB_TOPGEN], 1u);
            else XB_SPIN(xb_ld(&bar[XB_TOPGEN]) == tg, bar);
            __builtin_amdgcn_fence(__ATOMIC_ACQUIRE, "agent");
            xb_add(&bar[XB_XGEN(b.x)], 1u);
            asm volatile("s_waitcnt vmcnt(0)" ::: "memory");
        } else {
            XB_SPIN(xb_ld(&bar[XB_XGEN(b.x)]) == gen, bar);
            __builtin_amdgcn_fence(__ATOMIC_ACQUIRE, "agent");
            asm volatile("s_waitcnt vmcnt(0)" ::: "memory");
        }
    }
    __syncthreads();
}

struct Params { const float* in[13]; float* out; unsigned char* ws; };

__global__ void __launch_bounds__(NTHREADS, 2) fwd_kernel(Params p) {
    extern __shared__ __attribute__((aligned(16))) unsigned char lds_raw[];
    cg::grid_group grid = cg::this_grid();
    LAS unsigned char* lds = (LAS unsigned char*)lds_raw;
    const int tid = threadIdx.x, lane = tid & 63, wave = __builtin_amdgcn_readfirstlane(tid >> 6);
    const int G = gridDim.x, gw = blockIdx.x * NWAVES + wave, NGW = G * NWAVES;
    unsigned char* ws = p.ws;
    const float* x = p.in[0]; const float* norm_mix = p.in[1]; const float* w_in = p.in[2]; const float* w_sb = p.in[3]; const float* w_ca = p.in[4];
    const float* relb = p.in[5]; const float* w_out = p.in[6]; const float* norm_ffn = p.in[7]; const float* wq = p.in[8]; const float* subk = p.in[9];
    const float* pu = p.in[10]; const float* pv = p.in[11]; const float* norm_final = p.in[12];
    float* ssq = (float*)(ws + WS_SSQ);
    bf16* Win_t = (bf16*)(ws + WS_WIN); bf16* Psb_t = (bf16*)(ws + WS_PSB); bf16* Pca_t = (bf16*)(ws + WS_PCA); bf16* Wout_t = (bf16*)(ws + WS_WOUT); bf16* Wsc_t = (bf16*)(ws + WS_WSC);
    unsigned char* U8 = ws + WS_U; unsigned char* V8 = ws + WS_V; float* SU = (float*)(ws + WS_SU); float* SV = (float*)(ws + WS_SV); float* rstd2 = (float*)(ws + WS_RSTD); float* SSQ2 = (float*)(ws + WS_SSQ2);
    int* eidx = (int*)(ws + WS_IDX); float* egw = (float*)(ws + WS_GW);
    bf16* S0 = (bf16*)(ws + WS_SLOT0); bf16* S1 = (bf16*)(ws + WS_SLOT0 + SLOT); bf16* S2 = (bf16*)(ws + WS_SLOT0 + 2 * SLOT); bf16* S3 = (bf16*)(ws + WS_SLOT0 + 3 * SLOT);
    bf16* S4 = (bf16*)(ws + WS_SLOT0 + 4 * SLOT); bf16* S5 = (bf16*)(ws + WS_SLOT0 + 5 * SLOT);
    bf16* o_sb = S0; bf16* o_ca = S0 + 512;
    bf16* xbf = (bf16*)p.out;
    unsigned short* scores = (unsigned short*)S1;

    unsigned* barw = (unsigned*)ws;
    volatile LAS unsigned* bst = (volatile LAS unsigned*)(lds + LDS_MISC_OFF);
    if (tid < 2) bst[tid] = 0u;
    __syncthreads();
    const XcdBarrier xb = xcd_barrier_post(barw, bst);
    if (p.ws == nullptr) grid.sync();
    {
        LAS float* scr = (LAS float*)(lds + wave * 16384);
        constexpr int I_IN = (1024 / 64) * (5120 / 32), I_SB = (512 / 64) * (1024 / 32), I_OUT = (1024 / 64) * (1024 / 32), I_WSC = 2048;
        constexpr int NITEMS = I_IN + 2 * I_SB + I_OUT + I_WSC;
        for (int it = gw; it < NITEMS; it += NGW) {
            int r = it;
            if (r < I_WSC) { p0_wsc_item(wq, subk, norm_ffn, Wsc_t, r, lane); continue; } r -= I_WSC;
            if (r < I_IN) { p0_transpose_item(w_in, 1024, 5120, Win_t, scr, r, lane); continue; } r -= I_IN;
            if (r < I_SB) { p0_transpose_item(w_sb, 512, 1024, Psb_t, scr, r, lane, 1024); continue; } r -= I_SB;
            if (r < I_SB) { p0_transpose_item(w_ca, 512, 1024, Psb_t + 512, scr, r, lane, 1024); continue; } r -= I_SB;
            p0_transpose_item(w_out, 1024, 1024, Wout_t, scr, r, lane);
        }
        { f32x4 va[4], vb[4], na[4], nb[4];
          constexpr int NR1 = T;
          row_load16(va, x + (size_t)gw * D, lane); row_load16(vb, x + (size_t)(gw + NGW < NR1 ? gw + NGW : gw) * D, lane);
          for (int m = gw; m < NR1; m += 2 * NGW) {
              const int mb = m + NGW, ma2 = m + 2 * NGW < NR1 ? m + 2 * NGW : m, mb2 = m + 3 * NGW < NR1 ? m + 3 * NGW : m;
              row_load16(na, x + (size_t)ma2 * D, lane); row_load16(nb, x + (size_t)mb2 * D, lane);
              rms_row_finish(va, norm_mix, S0 + (size_t)m * D, xbf + (size_t)m * D, lane);
              if (mb < NR1) rms_row_finish(vb, norm_mix, S0 + (size_t)mb * D, xbf + (size_t)mb * D, lane);
#pragma unroll
              for (int j = 0; j < 4; ++j) { va[j] = na[j]; vb[j] = nb[j]; }
          }
          constexpr int NR2 = 2 * 16384;
#define TABROW(r_) ((r_) < 16384 ? pu + (size_t)(r_) * 1024 : pv + (size_t)((r_) - 16384) * 1024)
#define TABFIN(v_, r_) do { if ((r_) < 16384) int4_row_finish(v_, norm_ffn, U8 + (size_t)(r_) * 128, SU + (r_), lane); else fp8_row_finish(v_, nullptr, V8 + (size_t)((r_) - 16384) * 128, SV + ((r_) - 16384), lane); } while (0)
          fp8_row_load(va, TABROW(gw), lane); { const int r1 = gw + NGW < NR2 ? gw + NGW : gw; fp8_row_load(vb, TABROW(r1), lane); }
          for (int r = gw; r < NR2; r += 2 * NGW) {
              const int rb = r + NGW, ra2 = r + 2 * NGW < NR2 ? r + 2 * NGW : r, rb2 = r + 3 * NGW < NR2 ? r + 3 * NGW : r;
              fp8_row_load(na, TABROW(ra2), lane); fp8_row_load(nb, TABROW(rb2), lane);
              TABFIN(va, r);
              if (rb < NR2) TABFIN(vb, rb);
#pragma unroll
              for (int j = 0; j < 4; ++j) { va[j] = na[j]; vb[j] = nb[j]; }
          }
#undef TABROW
#undef TABFIN
        }
    }
    xcd_barrier(xb);
    {
        pg8::Gemm g{S0, Win_t, T, 5120, 1024}; pg8::StaticOrder S; S.init(T, 5120, G, (int)blockIdx.x);
        pg8::EpiBf16<0> E{S1, 1024, nullptr, 1024, SLOT / 2, 1.f};
        pg8::gemm_phase<pg8::EpiBf16<0>, pg8::StaticOrder, true, true>(lds, g, S, E);
    }
    xcd_barrier(xb);
    {
        LAS float* biasl = (LAS float*)(lds + LDS_BIAS_OFF);
        for (int i = tid; i < 8 * 257; i += NTHREADS) biasl[i] = relb[i] * LOG2E;
        __syncthreads();
        for (int u = blockIdx.x; u < 2048; u += G) {
            if (u < 1024) ca_wg_unit(u, lds, biasl, S2, S3, o_ca, wave, lane);
            else sb_wg_unit(u - 1024, lds, S1, S2, o_sb, wave, lane);
        }
        asm volatile("s_waitcnt vmcnt(0)" ::: "memory");
    }
    xcd_barrier(xb);
    {
        pg8::Gemm g{S0, Psb_t, T, 1024, 1024}; pg8::StaticOrder S; S.init(T, 1024, G, (int)blockIdx.x);
        EpiGateAB E{S4, S5, S2};
        pg8::gemm_phase<EpiGateAB, pg8::StaticOrder, true, true>(lds, g, S, E);
    }
    xcd_barrier(xb);
    {
        pg8::Gemm g{S2, Wout_t, T, 1024, 1024}; pg8::StaticOrder S; S.init(T, 1024, G, (int)blockIdx.x);
        EpiResid E{xbf, S0, ssq};
        pg8::gemm_phase<EpiResid, pg8::StaticOrder, true, true>(lds, g, S, E);
    }
    xcd_barrier(xb);
    {
        pg8::Gemm g{S0, Wsc_t, T, 2048, 1024}; pg8::StaticOrder S; S.init(T, 2048, G, (int)blockIdx.x);
        LAS float* rl = (LAS float*)(lds + 131072);
        for (int i = tid >> 8; ; i += 2) { pg8::Unit u; if (!S.next(i, u) || i >= 16) break;
            const int row = u.pm * 256 + (tid & 255);
            const f32x4* sp = (const f32x4*)(ssq + (size_t)row * 16); const f32x4 s0 = sp[0], s1 = sp[1], s2 = sp[2], s3 = sp[3];
            const float tot = ((s0.x + s0.y) + (s0.z + s0.w)) + ((s1.x + s1.y) + (s1.z + s1.w)) + ((s2.x + s2.y) + (s2.z + s2.w)) + ((s3.x + s3.y) + (s3.z + s3.w));
            rl[256 * i + (tid & 255)] = rsqrtf(tot * (1.f / 1024.f) + RMS_EPS); }
        __syncthreads();
        EpiScore E{rl, scores, 0};
        pg8::gemm_phase<EpiScore, pg8::StaticOrder, true, true>(lds, g, S, E);
        for (int j = wave; ; j += NWAVES) {
            pg8::Unit u; if (!S.next(j >> 2, u)) break;
            topk_task((4 * u.pm + (j & 3)) * 8 + u.pn, scores, eidx, egw, (LAS int*)(lds + wave * 16384), lane);
        }
        for (int t = blockIdx.x * NTHREADS + tid; t < T; t += G * NTHREADS) {
            const f32x4* sp = (const f32x4*)(ssq + (size_t)t * 16); const f32x4 s0 = sp[0], s1 = sp[1], s2 = sp[2], s3 = sp[3];
            const float tot = ((s0.x + s0.y) + (s0.z + s0.w)) + ((s1.x + s1.y) + (s1.z + s1.w)) + ((s2.x + s2.y) + (s2.z + s2.w)) + ((s3.x + s3.y) + (s3.z + s3.w));
            rstd2[t] = rsqrtf(tot * (1.f / 1024.f) + RMS_EPS);
        }
    }
    xcd_barrier(xb);
    {
        _Float16* PD = (_Float16*)S3;
        const bool sliced = (G % 4 == 0) && (G / 4 * NWAVES == P7_WPS);
        const int slice = blockIdx.x & 3, wrank = (blockIdx.x >> 2) * NWAVES + wave;
        if (sliced) p7a_phase(slice, wrank, S0, U8, eidx, PD, lane, (LAS unsigned*)(lds + wave * 1024));
        xcd_barrier(xb);
        if (sliced) p7b_phase(gw, NGW, PD, eidx, egw, SU, SV, rstd2, lane, (LAS float*)lds, tid);
        xcd_barrier(xb);
        if (sliced) p7c_phase(slice, wrank, S0, S4, V8, eidx, egw, SSQ2, lane);
        xcd_barrier(xb);
        if (sliced) p7d_phase(gw, NGW, S4, p.out, SSQ2, norm_final, lane);
    }
}

extern "C" void kernel_launch(void* const* d_in, const int* in_sizes, int n_in, void* d_out, int out_size, void* d_ws, size_t ws_size, hipStream_t stream) {
    static int grid = 0;
    if (grid == 0) {
        if (n_in != 13 || in_sizes[0] != T * D || out_size != T * D || ws_size < WS_END) {
            fprintf(stderr, "kernel_launch: built for 13 inputs, x/out of %d floats, >= %zu bytes of workspace; got n_in %d, in0 %d, out %d, ws %zu; nothing launched\n", T * D, (size_t)WS_END, n_in, n_in > 0 ? in_sizes[0] : -1, out_size, ws_size);
            grid = -1; return; }
        int dev = 0, cus = 0, per_cu = 0;
        if (hipGetDevice(&dev) != hipSuccess || hipDeviceGetAttribute(&cus, hipDeviceAttributeMultiprocessorCount, dev) != hipSuccess) { fprintf(stderr, "kernel_launch: device query failed\n"); grid = -1; return; }
        if (hipFuncSetAttribute((const void*)fwd_kernel, hipFuncAttributeMaxDynamicSharedMemorySize, LDS_BYTES) != hipSuccess) { fprintf(stderr, "kernel_launch: hipFuncSetAttribute failed\n"); grid = -1; return; }
        if (hipOccupancyMaxActiveBlocksPerMultiprocessor(&per_cu, (const void*)fwd_kernel, NTHREADS, LDS_BYTES) != hipSuccess || per_cu < 1) { fprintf(stderr, "kernel_launch: occupancy query says %d blocks per CU\n", per_cu); (void)hipGetLastError(); grid = -1; return; }
        grid = cus * 1;
    }
    if (grid < 0) return;
    if (hipMemsetAsync(d_ws, 0, 16384, stream) != hipSuccess) { fprintf(stderr, "kernel_launch: hipMemsetAsync of the barrier words failed\n"); return; }
    Params p{};
    for (int i = 0; i < 13; ++i) p.in[i] = (const float*)d_in[i];
    p.out = (float*)d_out; p.ws = (unsigned char*)d_ws;
    void* args[] = {&p};
    hipError_t e = hipLaunchCooperativeKernel((const void*)fwd_kernel, dim3(grid), dim3(NTHREADS), args, LDS_BYTES, stream);
    if (e != hipSuccess) fprintf(stderr, "kernel_launch: cooperative launch failed: %s (grid %d)\n", hipGetErrorString(e), grid);
}
```

```cpp
#include <hip/hip_runtime.h>
#include <hip/hip_cooperative_groups.h>
#include <cstdio>
#include <cstdint>
namespace cg = cooperative_groups;
namespace pg8 {
#define PG8_LAS __attribute__((address_space(3)))
typedef unsigned short bf16_t;
typedef short bf16x8 __attribute__((ext_vector_type(8)));
typedef float f32x4 __attribute__((ext_vector_type(4)));
typedef unsigned u32x4 __attribute__((ext_vector_type(4)));
constexpr int BM = 256, BK = 64, HALF = 128, HTB = HALF * BK * 2  , STAGE_BYTES = 8 * HTB, NXCD = 8, WGM = 8;

__host__ __device__ __forceinline__ int lds_byte(int r, int c) { const int st = (r >> 4) * 2 + (c >> 5), rr = r & 15, cc = c & 31, ob = rr * 64 + cc * 2; return st * 1024 + (ob ^ (((ob >> 9) & 1) << 5)); }
__host__ __device__ __forceinline__ void stage_rc(int b, int& R, int& C) { const int st = b / 1024, sb = b % 1024, swz = sb ^ (((sb >> 9) & 1) << 5); R = (st >> 1) * 16 + swz / 64; C = (st & 1) * 32 + (swz % 64) / 2; }
__host__ __device__ __forceinline__ int perm32(int rho) { const int n = rho >> 4, i = rho & 15; return 8 * (i >> 2) + 4 * n + (i & 3); }

struct Unit { int pm, pn; };
struct Gemm { const bf16_t* A; const bf16_t* Bt; int M, N, K; };

struct StaticOrder {
    int nM, nN, nwg, G, c;
    __host__ __device__ void init(int M, int N, int G_, int c_) { nM = M / BM; nN = N / BM; nwg = nM * nN; G = G_; c = c_; }
    __host__ __device__ bool next(int i, Unit& u) const {
        const long L = (long)i * G + c; if (L >= nwg) return false;
        int wgid = (int)L; { const int q = nwg / NXCD, r = nwg % NXCD, xcd = wgid % NXCD, off = wgid / NXCD; wgid = (xcd < r ? xcd * (q + 1) : r * (q + 1) + (xcd - r) * q) + off; }
        const int nig = WGM * nN, gid = wgid / nig, fm = gid * WGM, gsz = (nM - fm) < WGM ? (nM - fm) : WGM;
        u.pm = fm + ((wgid % nig) % gsz); u.pn = (wgid % nig) / gsz; return true;
    }
    __device__ __forceinline__ void a_ready(const Unit&) const {}
    __device__ __forceinline__ void done(const Unit&) const {}
};

__device__ __forceinline__ unsigned cvt_pk_bf16(float lo, float hi) { unsigned r; asm volatile("v_cvt_pk_bf16_f32 %0, %1, %2" : "=v"(r) : "v"(lo), "v"(hi)); return r; }
typedef float f32x2 __attribute__((ext_vector_type(2)));
__device__ __forceinline__ f32x2 gelu_pk(f32x2 v) {
    const f32x2 av = __builtin_elementwise_abs(v), d = av * 0.2316418882f + 1.0f;
    f32x2 t; t.x = __builtin_amdgcn_rcpf(d.x); t.y = __builtin_amdgcn_rcpf(d.y);
    f32x2 q = t * 0.5307027145f + (-0.7265760135f); q = q * t + 0.7107068705f; q = q * t + (-0.142248368f); q = q * t + 0.127414796f; q = q * t;
    const f32x2 s = (v * v) * (-0.72134752044f);
    f32x2 e; e.x = __builtin_amdgcn_exp2f(s.x); e.y = __builtin_amdgcn_exp2f(s.y);
    const f32x2 m = v * (q * e), r = v - m;
    f32x2 o; o.x = v.x < 0.f ? m.x : r.x; o.y = v.y < 0.f ? m.y : r.y; return o;
}

template <int ACT  > struct EpiBf16 {
    static constexpr bool PERM = true, AFTER_DRAIN = false; static_assert(ACT == 0 || ACT == 1, "EpiBf16: ACT is 0 (none) or 1 (gelu_pk)");
    bf16_t* O; int ldc; const float* bias; int split_cols; size_t split_stride; float scale0;
    __device__ __forceinline__ void operator()(const f32x4 (&acc)[2][2][4][2], const Unit& u, int wr, int wc, int fr, int fq) const {
        const int row0 = u.pm * BM + wr * 64 + fr; int colt = u.pn * BM; bf16_t* base = O;
        float sc = 1.f; if (split_cols) { const int t = colt / split_cols; base += (size_t)t * split_stride; colt -= t * split_cols; if (t == 0) sc = scale0; }
        const int col0 = colt + wc * 32 + 8 * fq, bcol0 = u.pn * BM + wc * 32 + 8 * fq;
        f32x4 bv[2][2];
#pragma unroll
        for (int bj = 0; bj < 2; ++bj)
#pragma unroll
            for (int n = 0; n < 2; ++n) bv[bj][n] = bias ? *(const f32x4*)(bias + bcol0 + bj * HALF + 4 * n) : (f32x4){0.f, 0.f, 0.f, 0.f};
#pragma unroll
        for (int ai = 0; ai < 2; ++ai)
#pragma unroll
            for (int m = 0; m < 4; ++m) { bf16_t* rowp = base + (size_t)(row0 + ai * HALF + m * 16) * ldc + col0;
#pragma unroll
                for (int bj = 0; bj < 2; ++bj) { f32x4 v0 = acc[ai][bj][m][0] + bv[bj][0], v1 = acc[ai][bj][m][1] + bv[bj][1];
                    if (ACT == 1) { f32x2 a = gelu_pk((f32x2){v0[0], v0[1]}), b = gelu_pk((f32x2){v0[2], v0[3]}), c = gelu_pk((f32x2){v1[0], v1[1]}), d = gelu_pk((f32x2){v1[2], v1[3]});
                        v0 = (f32x4){a.x, a.y, b.x, b.y}; v1 = (f32x4){c.x, c.y, d.x, d.y}; }
                    v0 = v0 * sc; v1 = v1 * sc; u32x4 w; w.x = cvt_pk_bf16(v0[0], v0[1]); w.y = cvt_pk_bf16(v0[2], v0[3]); w.z = cvt_pk_bf16(v1[0], v1[1]); w.w = cvt_pk_bf16(v1[2], v1[3]);
                    *(u32x4*)(rowp + bj * HALF) = w; } }
    }
};
template <class E, class = void> struct has_midk { static constexpr bool value = false; };
template <class E> struct has_midk<E, decltype((void)E::MIDK)> { static constexpr bool value = E::MIDK; };
template <class Epi, class Sched, bool ALIGN_EPI = false, bool SP2 = false>
__device__ __forceinline__ void gemm_phase(PG8_LAS unsigned char* lds, const Gemm g, const Sched& S, const Epi& E) {
    int tid_ = threadIdx.x; asm volatile("" : "+v"(tid_));
    const int tid = tid_, wid = __builtin_amdgcn_readfirstlane(tid >> 6), lane = tid & 63, wr = wid >> 2, wc = wid & 3, fr = lane & 15, fq = lane >> 4;
    const int K = g.K, nt = K / BK;
    unsigned voffA[2], voffB[2];
#pragma unroll
    for (int i = 0; i < 2; ++i) { int R, C; stage_rc(tid * 16 + i * 8192, R, C); const int Rb = Epi::PERM ? ((R & ~31) + perm32(R & 31)) : R;
        voffA[i] = (unsigned)(R * K + C) * 2u; voffB[i] = (unsigned)(Rb * K + C) * 2u; }
    const size_t kstep = (size_t)(BK * 2);
    const size_t hstep = (size_t)HALF * K * 2;
    const size_t tstep = 2 * hstep;
    const unsigned ldsw = (unsigned)wid * 1024u;
    const int aoff = lds_byte(wr * 64 + fr, fq * 8), boff = lds_byte(wc * 32 + fr, fq * 8);
#define PG8_SA(b, h) (((b) * 2 + (h)) * HTB)
#define PG8_SB(b, h) ((4 + (b) * 2 + (h)) * HTB)
#define PG8_STAGE(bufoff, gbase, voff) do { _Pragma("unroll") for (int _i = 0; _i < 2; ++_i) \
        __builtin_amdgcn_global_load_lds((const unsigned*)((const char*)(gbase) + (voff)[_i]), (PG8_LAS unsigned*)(lds + (bufoff) + ldsw + _i * 8192), 16, 0, 0); } while (0)
#define PG8_LDA(dst, b, h) do { _Pragma("unroll") for (int m = 0; m < 4; ++m) _Pragma("unroll") for (int k = 0; k < 2; ++k) dst[m][k] = *(const PG8_LAS bf16x8*)(lds + PG8_SA(b, h) + aoff + m * 2048 + k * 1024); } while (0)
#define PG8_LDB(dst, b, h) do { _Pragma("unroll") for (int n = 0; n < 2; ++n) _Pragma("unroll") for (int k = 0; k < 2; ++k) dst[n][k] = *(const PG8_LAS bf16x8*)(lds + PG8_SB(b, h) + boff + n * 2048 + k * 1024); } while (0)
#define PG8_MMA(ai, bj, At, Bt) do { __builtin_amdgcn_s_setprio(1); _Pragma("unroll") for (int m = 0; m < 4; ++m) _Pragma("unroll") for (int n = 0; n < 2; ++n) _Pragma("unroll") for (int k = 0; k < 2; ++k) \
        acc[ai][bj][m][n] = __builtin_amdgcn_mfma_f32_16x16x32_bf16(Bt[n][k], At[m][k], acc[ai][bj][m][n], 0, 0, 0); __builtin_amdgcn_s_setprio(0); } while (0)
#define PG8_WAIT_V(n) asm volatile("s_waitcnt vmcnt(" #n ")" ::: "memory")
#define PG8_WAIT_L(n) asm volatile("s_waitcnt lgkmcnt(" #n ")" ::: "memory")
#define PG8_BAR __builtin_amdgcn_s_barrier()
#define PG8_SCHED __builtin_amdgcn_sched_barrier(0)
    Unit cur, nxt; int ui = 0;
    if (!S.next(0, cur)) return;
    f32x4 acc[2][2][4][2];
#pragma unroll
    for (int a = 0; a < 2; ++a)
#pragma unroll
        for (int b = 0; b < 2; ++b)
#pragma unroll
            for (int m = 0; m < 4; ++m)
#pragma unroll
                for (int n = 0; n < 2; ++n) acc[a][b][m][n] = (f32x4){0.f, 0.f, 0.f, 0.f};
    bf16x8 At[4][2], B0[2][2], B1[2][2];
    const char* cA = (const char*)g.A + (size_t)cur.pm * tstep; const char* cB = (const char*)g.Bt + (size_t)cur.pn * tstep;
    S.a_ready(cur);
    if constexpr (SP2) {
        PG8_STAGE(PG8_SB(0, 0), cB, voffB); PG8_STAGE(PG8_SB(0, 1), cB + hstep, voffB); PG8_STAGE(PG8_SA(0, 0), cA, voffA); PG8_STAGE(PG8_SA(0, 1), cA + hstep, voffA);
        if (wr == 1) PG8_BAR;
        PG8_WAIT_V(2); PG8_BAR;
        PG8_STAGE(PG8_SB(1, 0), cB + kstep, voffB); PG8_STAGE(PG8_SA(1, 0), cA + kstep, voffA); PG8_STAGE(PG8_SB(1, 1), cB + hstep + kstep, voffB);
        PG8_WAIT_V(6); PG8_BAR;
    } else {
        PG8_STAGE(PG8_SB(0, 0), cB, voffB); PG8_STAGE(PG8_SA(0, 0), cA, voffA); PG8_STAGE(PG8_SB(0, 1), cB + hstep, voffB); PG8_STAGE(PG8_SA(0, 1), cA + hstep, voffA);
        if (wr == 1) PG8_BAR;
        PG8_WAIT_V(4); PG8_BAR;
        PG8_STAGE(PG8_SB(1, 0), cB + kstep, voffB); PG8_STAGE(PG8_SA(1, 0), cA + kstep, voffA); PG8_STAGE(PG8_SB(1, 1), cB + hstep + kstep, voffB);
        PG8_WAIT_V(6); PG8_BAR;
    }
    for (;;) {
        const bool has_next = S.next(ui + 1, nxt);
        const char* nA = has_next ? (const char*)g.A + (size_t)nxt.pm * tstep : cA; const char* nB = has_next ? (const char*)g.Bt + (size_t)nxt.pn * tstep : cB;
        constexpr int NSEG = has_midk<Epi>::value ? 2 : 1;
        for (int seg = 0; seg < NSEG; ++seg) {
        if constexpr (has_midk<Epi>::value) { if (seg == 1) E.mid(acc, cur, wr, wc, fr, fq); }
        for (int t = seg * (nt / NSEG); t < (seg + 1) * (nt / NSEG); t += 2) {
            const bool last = (t == nt - 2);
            const char* a1 = cA + (size_t)(t + 1) * kstep;
            const char* a2 = last ? nA : cA + (size_t)(t + 2) * kstep; const char* b2 = last ? nB : cB + (size_t)(t + 2) * kstep;
            const char* a3 = a2 + kstep; const char* b3 = b2 + kstep;
            if (last && has_next) S.a_ready(nxt);
            if constexpr (SP2) {
            PG8_LDB(B0, 0, 0); PG8_LDB(B1, 0, 1); PG8_SCHED; PG8_LDA(At, 0, 0); PG8_STAGE(PG8_SA(1, 1), a1 + hstep, voffA);
            PG8_WAIT_V(8); PG8_WAIT_L(0); PG8_BAR; PG8_MMA(0, 0, At, B0); PG8_MMA(0, 1, At, B1); PG8_BAR; PG8_SCHED;
            PG8_LDA(At, 0, 1); PG8_STAGE(PG8_SB(0, 0), b2, voffB); PG8_STAGE(PG8_SB(0, 1), b2 + hstep, voffB); PG8_STAGE(PG8_SA(0, 0), a2, voffA);
            PG8_WAIT_V(8); PG8_WAIT_L(0); PG8_BAR; PG8_MMA(1, 0, At, B0); PG8_MMA(1, 1, At, B1); PG8_BAR; PG8_SCHED;
            PG8_LDB(B0, 1, 0); PG8_LDB(B1, 1, 1); PG8_SCHED; PG8_LDA(At, 1, 0); PG8_STAGE(PG8_SA(0, 1), a2 + hstep, voffA);
            PG8_WAIT_V(8); PG8_WAIT_L(0); PG8_BAR; PG8_MMA(0, 0, At, B0); PG8_MMA(0, 1, At, B1); PG8_BAR; PG8_SCHED;
            PG8_LDA(At, 1, 1); PG8_STAGE(PG8_SB(1, 0), b3, voffB); PG8_STAGE(PG8_SB(1, 1), b3 + hstep, voffB); PG8_STAGE(PG8_SA(1, 0), a3, voffA);
            PG8_WAIT_V(8); PG8_WAIT_L(0); PG8_BAR; PG8_MMA(1, 0, At, B0); PG8_MMA(1, 1, At, B1); PG8_BAR; PG8_SCHED;
            } else {
            PG8_LDB(B0, 0, 0); PG8_SCHED; PG8_LDA(At, 0, 0); PG8_STAGE(PG8_SA(1, 1), a1 + hstep, voffA);
            PG8_WAIT_L(8); PG8_BAR; PG8_WAIT_L(0); PG8_MMA(0, 0, At, B0); PG8_BAR; PG8_SCHED;
            PG8_LDB(B1, 0, 1); PG8_STAGE(PG8_SB(0, 0), b2, voffB);
            PG8_BAR; PG8_WAIT_L(0); PG8_MMA(0, 1, At, B1); PG8_BAR;
            PG8_LDA(At, 0, 1); PG8_STAGE(PG8_SA(0, 0), a2, voffA);
            PG8_BAR; PG8_WAIT_L(0); PG8_MMA(1, 0, At, B0); PG8_BAR; PG8_SCHED;
            PG8_STAGE(PG8_SB(0, 1), b2 + hstep, voffB);
            PG8_WAIT_V(6); PG8_BAR; PG8_MMA(1, 1, At, B1); PG8_BAR;
            PG8_LDB(B0, 1, 0); PG8_SCHED; PG8_LDA(At, 1, 0); PG8_STAGE(PG8_SA(0, 1), a2 + hstep, voffA);
            PG8_WAIT_L(8); PG8_BAR; PG8_WAIT_L(0); PG8_MMA(0, 0, At, B0); PG8_BAR; PG8_SCHED;
            PG8_LDB(B1, 1, 1); PG8_STAGE(PG8_SB(1, 0), b3, voffB);
            PG8_BAR; PG8_WAIT_L(0); PG8_MMA(0, 1, At, B1); PG8_BAR;
            PG8_LDA(At, 1, 1); PG8_STAGE(PG8_SA(1, 0), a3, voffA);
            PG8_BAR; PG8_WAIT_L(0); PG8_MMA(1, 0, At, B0); PG8_BAR; PG8_SCHED;
            PG8_STAGE(PG8_SB(1, 1), b3 + hstep, voffB);
            PG8_WAIT_V(6); PG8_BAR; PG8_MMA(1, 1, At, B1); PG8_BAR;
            }
        }
        }
        if constexpr (ALIGN_EPI) { if (wr == 0) PG8_BAR; }
        if constexpr (!Epi::AFTER_DRAIN) { E(acc, cur, wr, wc, fr, fq); S.done(cur); }
        if (!has_next) break;
#pragma unroll
        for (int a = 0; a < 2; ++a)
#pragma unroll
            for (int b = 0; b < 2; ++b)
#pragma unroll
                for (int m = 0; m < 4; ++m)
#pragma unroll
                    for (int n = 0; n < 2; ++n) acc[a][b][m][n] = (f32x4){0.f, 0.f, 0.f, 0.f};
        cur = nxt; cA = nA; cB = nB; ++ui;
        if constexpr (ALIGN_EPI) { if (wr == 1) PG8_BAR; }
    }
    PG8_WAIT_V(0);
    if constexpr (!ALIGN_EPI) { if (wr == 0) PG8_BAR; }
    PG8_BAR;
    if constexpr (Epi::AFTER_DRAIN) { E.fused(acc, cur, wr, wc, fr, fq, lds, wid, lane); S.done(cur); }
#undef PG8_SA
#undef PG8_SB
#undef PG8_STAGE
#undef PG8_LDA
#undef PG8_LDB
#undef PG8_MMA
#undef PG8_WAIT_V
#undef PG8_WAIT_L
#undef PG8_BAR
#undef PG8_SCHED
}
}

constexpr int D = 1024, BATCH = 4, SEQ = 8192, T = BATCH * SEQ;
constexpr int NWAVES = 8, NTHREADS = NWAVES * 64;
constexpr float RMS_EPS = 1e-6f;
constexpr float LOG2E = 1.4426950408889634f;
constexpr float QSCALE = 0.125f * LOG2E;

#define LAS __attribute__((address_space(3)))
typedef unsigned short bf16;
typedef unsigned u32x4 __attribute__((ext_vector_type(4)));
typedef unsigned u32x2 __attribute__((ext_vector_type(2)));
typedef float f32x4 __attribute__((ext_vector_type(4)));

constexpr size_t MiB = 1u << 20;
constexpr size_t WS_SSQ = 1 * MiB;
constexpr size_t WS_WIN = 3 * MiB;
constexpr size_t WS_PSB = 13 * MiB;
constexpr size_t WS_PCA = 14 * MiB;
constexpr size_t WS_WOUT = 15 * MiB;
constexpr size_t WS_WSC = 17 * MiB;
constexpr size_t WS_U = 21 * MiB;
constexpr size_t WS_V = 37 * MiB;
constexpr size_t WS_SU = 53 * MiB;
constexpr size_t WS_SV = 53 * MiB + 65536;
constexpr size_t WS_RSTD = 53 * MiB + 131072;
constexpr size_t WS_SSQ2 = 54 * MiB;
constexpr size_t WS_IDX = 85 * MiB;
constexpr size_t WS_GW = 101 * MiB;
constexpr size_t WS_SLOT0 = 120 * MiB;
constexpr size_t SLOT = 64 * MiB;
constexpr size_t WS_END = WS_SLOT0 + 6 * SLOT;
constexpr int LDS_BYTES = 147456;
constexpr int LDS_BIAS_OFF = 131072;
constexpr int LDS_MISC_OFF = 143360;

__device__ __forceinline__ float bf_lo(unsigned u) { return __uint_as_float(u << 16); }
__device__ __forceinline__ float bf_hi(unsigned u) { return __uint_as_float(u & 0xffff0000u); }
__device__ __forceinline__ unsigned f2bf(float f) { unsigned u = __float_as_uint(f); return (u + 0x7fffu + ((u >> 16) & 1u)) >> 16; }
typedef __bf16 bf16x2_t __attribute__((ext_vector_type(2)));
typedef float f32x2 __attribute__((ext_vector_type(2)));
__device__ __forceinline__ unsigned pk2(float lo, float hi) { const f32x2 v = {lo, hi}; return __builtin_bit_cast(unsigned, __builtin_convertvector(v, bf16x2_t)); }
__device__ __forceinline__ float dot2bf(unsigned a, unsigned b, float c) { return __builtin_amdgcn_fdot2_f32_bf16(__builtin_bit_cast(bf16x2_t, a), __builtin_bit_cast(bf16x2_t, b), c, false); }
__device__ __forceinline__ float wave_sum(float v) {
    v += __int_as_float(__builtin_amdgcn_mov_dpp(__float_as_int(v), 0xB1, 0xf, 0xf, true));
    v += __int_as_float(__builtin_amdgcn_mov_dpp(__float_as_int(v), 0x4E, 0xf, 0xf, true));
    v += __int_as_float(__builtin_amdgcn_mov_dpp(__float_as_int(v), 0x141, 0xf, 0xf, true));
    v += __int_as_float(__builtin_amdgcn_mov_dpp(__float_as_int(v), 0x140, 0xf, 0xf, true));
    { const auto r = __builtin_amdgcn_permlane16_swap(__float_as_uint(v), __float_as_uint(v), false, false); v = __uint_as_float(r[0]) + __uint_as_float(r[1]); }
    { const auto r = __builtin_amdgcn_permlane32_swap(__float_as_uint(v), __float_as_uint(v), false, false); v = __uint_as_float(r[0]) + __uint_as_float(r[1]); }
    return v;
}
__device__ __forceinline__ float fexp2(float x) { return __builtin_amdgcn_exp2f(x); }
__device__ __forceinline__ float flog2(float x) { return __builtin_amdgcn_logf(x); }
__device__ __forceinline__ float sigmoidf_fast(float x) { return __builtin_amdgcn_rcpf(1.f + fexp2(-x * LOG2E)); }

__device__ __forceinline__ u32x4 gate8(const u32x4 g, const pg8::f32x4 v0, const pg8::f32x4 v1) {
    u32x4 w;
    w.x = pg8::cvt_pk_bf16(sigmoidf_fast(bf_lo(g.x)) * v0[0], sigmoidf_fast(bf_hi(g.x)) * v0[1]);
    w.y = pg8::cvt_pk_bf16(sigmoidf_fast(bf_lo(g.y)) * v0[2], sigmoidf_fast(bf_hi(g.y)) * v0[3]);
    w.z = pg8::cvt_pk_bf16(sigmoidf_fast(bf_lo(g.z)) * v1[0], sigmoidf_fast(bf_hi(g.z)) * v1[1]);
    w.w = pg8::cvt_pk_bf16(sigmoidf_fast(bf_lo(g.w)) * v1[2], sigmoidf_fast(bf_hi(g.w)) * v1[3]);
    return w;
}
__device__ __forceinline__ u32x4 gate8_add(const u32x4 g, const u32x4 p, const pg8::f32x4 v0, const pg8::f32x4 v1) {
    u32x4 w;
    w.x = pg8::cvt_pk_bf16(bf_lo(p.x) + sigmoidf_fast(bf_lo(g.x)) * v0[0], bf_hi(p.x) + sigmoidf_fast(bf_hi(g.x)) * v0[1]);
    w.y = pg8::cvt_pk_bf16(bf_lo(p.y) + sigmoidf_fast(bf_lo(g.y)) * v0[2], bf_hi(p.y) + sigmoidf_fast(bf_hi(g.y)) * v0[3]);
    w.z = pg8::cvt_pk_bf16(bf_lo(p.z) + sigmoidf_fast(bf_lo(g.z)) * v1[0], bf_hi(p.z) + sigmoidf_fast(bf_hi(g.z)) * v1[1]);
    w.w = pg8::cvt_pk_bf16(bf_lo(p.w) + sigmoidf_fast(bf_lo(g.w)) * v1[2], bf_hi(p.w) + sigmoidf_fast(bf_hi(g.w)) * v1[3]);
    return w;
}
__device__ __forceinline__ void pack_acc_half(u32x4 (&pk)[2][4], const pg8::f32x4 (&acc)[2][2][4][2], int ai) {
#pragma unroll
    for (int bj = 0; bj < 2; ++bj)
#pragma unroll
        for (int m = 0; m < 4; ++m) { const pg8::f32x4 v0 = acc[ai][bj][m][0], v1 = acc[ai][bj][m][1];
            pk[bj][m] = (u32x4){pg8::cvt_pk_bf16(v0[0], v0[1]), pg8::cvt_pk_bf16(v0[2], v0[3]), pg8::cvt_pk_bf16(v1[0], v1[1]), pg8::cvt_pk_bf16(v1[2], v1[3])}; }
}
__device__ __forceinline__ u32x4 gate8p(const u32x4 g, const u32x4 a) {
    u32x4 w;
    w.x = pg8::cvt_pk_bf16(sigmoidf_fast(bf_lo(g.x)) * bf_lo(a.x), sigmoidf_fast(bf_hi(g.x)) * bf_hi(a.x));
    w.y = pg8::cvt_pk_bf16(sigmoidf_fast(bf_lo(g.y)) * bf_lo(a.y), sigmoidf_fast(bf_hi(g.y)) * bf_hi(a.y));
    w.z = pg8::cvt_pk_bf16(sigmoidf_fast(bf_lo(g.z)) * bf_lo(a.z), sigmoidf_fast(bf_hi(g.z)) * bf_hi(a.z));
    w.w = pg8::cvt_pk_bf16(sigmoidf_fast(bf_lo(g.w)) * bf_lo(a.w), sigmoidf_fast(bf_hi(g.w)) * bf_hi(a.w));
    return w;
}
__device__ __forceinline__ u32x4 gate8p_add(const u32x4 g, const u32x4 p, const u32x4 a) {
    u32x4 w;
    w.x = pg8::cvt_pk_bf16(bf_lo(p.x) + sigmoidf_fast(bf_lo(g.x)) * bf_lo(a.x), bf_hi(p.x) + sigmoidf_fast(bf_hi(g.x)) * bf_hi(a.x));
    w.y = pg8::cvt_pk_bf16(bf_lo(p.y) + sigmoidf_fast(bf_lo(g.y)) * bf_lo(a.y), bf_hi(p.y) + sigmoidf_fast(bf_hi(g.y)) * bf_hi(a.y));
    w.z = pg8::cvt_pk_bf16(bf_lo(p.z) + sigmoidf_fast(bf_lo(g.z)) * bf_lo(a.z), bf_hi(p.z) + sigmoidf_fast(bf_hi(g.z)) * bf_hi(a.z));
    w.w = pg8::cvt_pk_bf16(bf_lo(p.w) + sigmoidf_fast(bf_lo(g.w)) * bf_lo(a.w), bf_hi(p.w) + sigmoidf_fast(bf_hi(g.w)) * bf_hi(a.w));
    return w;
}
struct EpiGateA {
    static constexpr bool PERM = true, AFTER_DRAIN = false;
    const bf16* gate; bf16* out;
    __device__ __forceinline__ void operator()(const pg8::f32x4 (&acc)[2][2][4][2], const pg8::Unit& u, int wr, int wc, int fr, int fq) const {
        const size_t ro0 = (size_t)(u.pm * 256 + wr * 64 + fr) * 1024 + u.pn * 256 + wc * 32 + 8 * fq;
        u32x4 pk[2][2][4];
        pack_acc_half(pk[0], acc, 0); pack_acc_half(pk[1], acc, 1);
        u32x4 g[2][2][4];
#pragma unroll
        for (int ai = 0; ai < 2; ++ai)
#pragma unroll
            for (int bj = 0; bj < 2; ++bj)
#pragma unroll
                for (int m = 0; m < 4; ++m) g[ai][bj][m] = *(const u32x4*)(gate + ro0 + (size_t)(ai * 128 + m * 16) * 1024 + bj * 128);
#pragma unroll
        for (int ai = 0; ai < 2; ++ai)
#pragma unroll
            for (int bj = 0; bj < 2; ++bj)
#pragma unroll
                for (int m = 0; m < 4; ++m) *(u32x4*)(out + ro0 + (size_t)(ai * 128 + m * 16) * 1024 + bj * 128) = gate8p(g[ai][bj][m], pk[ai][bj][m]);
    }
};
__device__ __forceinline__ float gate_ratio(float xs, float xc) { return (1.f + fexp2(-fmaxf(xc, -80.f) * LOG2E)) * __builtin_amdgcn_rcpf(1.f + fexp2(-xs * LOG2E)); }
__device__ __forceinline__ float sigmoid_c80(float x) { return __builtin_amdgcn_rcpf(1.f + fexp2(-fmaxf(x, -80.f) * LOG2E)); }
struct EpiGateAB {
    static constexpr bool PERM = true, AFTER_DRAIN = false, MIDK = true;
    const bf16* gsb; const bf16* gca; bf16* out;
    __device__ __forceinline__ void batch_load(u32x4 (&a)[4], u32x4 (&b)[4], __amdgpu_buffer_rsrc_t rs, __amdgpu_buffer_rsrc_t rc, unsigned voff, unsigned soff) const {
#pragma unroll
        for (int m = 0; m < 4; ++m) { a[m] = __builtin_bit_cast(u32x4, __builtin_amdgcn_raw_buffer_load_b128(rs, voff, soff + (unsigned)(m * 16 * 1024 * 2), 0));
                                      b[m] = __builtin_bit_cast(u32x4, __builtin_amdgcn_raw_buffer_load_b128(rc, voff, soff + (unsigned)(m * 16 * 1024 * 2), 0)); }
    }
    __device__ __forceinline__ void batch_apply(pg8::f32x4 (&blk)[4][2], const u32x4 (&a)[4], const u32x4 (&b)[4]) const {
#pragma unroll
        for (int m = 0; m < 4; ++m) { pg8::f32x4& v0 = blk[m][0]; pg8::f32x4& v1 = blk[m][1];
            v0[0] *= gate_ratio(bf_lo(a[m].x), bf_lo(b[m].x)); v0[1] *= gate_ratio(bf_hi(a[m].x), bf_hi(b[m].x)); v0[2] *= gate_ratio(bf_lo(a[m].y), bf_lo(b[m].y)); v0[3] *= gate_ratio(bf_hi(a[m].y), bf_hi(b[m].y));
            v1[0] *= gate_ratio(bf_lo(a[m].z), bf_lo(b[m].z)); v1[1] *= gate_ratio(bf_hi(a[m].z), bf_hi(b[m].z)); v1[2] *= gate_ratio(bf_lo(a[m].w), bf_lo(b[m].w)); v1[3] *= gate_ratio(bf_hi(a[m].w), bf_hi(b[m].w)); }
    }
    __device__ __forceinline__ void mid(pg8::f32x4 (&acc)[2][2][4][2], const pg8::Unit& u, int wr, int wc, int fr, int fq) const {
        const __amdgpu_buffer_rsrc_t rs = __builtin_amdgcn_make_buffer_rsrc((void*)gsb, (short)0, T * 1024 * 2, 0x00020000), rc = __builtin_amdgcn_make_buffer_rsrc((void*)gca, (short)0, T * 1024 * 2, 0x00020000);
        const unsigned voff = (unsigned)((wr * 64 + fr) * 1024 + wc * 32 + 8 * fq) * 2u;
        const unsigned sb = (unsigned)(u.pm * 256 * 1024 + u.pn * 256) * 2u;
        u32x4 a0[4], b0[4], a1[4], b1[4];
        batch_load(a0, b0, rs, rc, voff, sb);                                    asm volatile("" ::: "memory");
        batch_load(a1, b1, rs, rc, voff, sb + 128u * 2u);                        asm volatile("" ::: "memory");
        batch_apply(acc[0][0], a0, b0);
        batch_load(a0, b0, rs, rc, voff, sb + 128u * 1024u * 2u);                asm volatile("" ::: "memory");
        batch_apply(acc[0][1], a1, b1);
        batch_load(a1, b1, rs, rc, voff, sb + 128u * 1024u * 2u + 128u * 2u);    asm volatile("" ::: "memory");
        batch_apply(acc[1][0], a0, b0);
        batch_apply(acc[1][1], a1, b1);
    }
    __device__ __forceinline__ void operator()(const pg8::f32x4 (&acc)[2][2][4][2], const pg8::Unit& u, int wr, int wc, int fr, int fq) const {
        const size_t ro0 = (size_t)(u.pm * 256 + wr * 64 + fr) * 1024 + u.pn * 256 + wc * 32 + 8 * fq;
#pragma unroll
        for (int ai = 0; ai < 2; ++ai) {
            u32x4 g[2][4];
#pragma unroll
            for (int bj = 0; bj < 2; ++bj)
#pragma unroll
                for (int m = 0; m < 4; ++m) g[bj][m] = *(const u32x4*)(gca + ro0 + (size_t)(ai * 128 + m * 16) * 1024 + bj * 128);
#pragma unroll
            for (int bj = 0; bj < 2; ++bj)
#pragma unroll
                for (int m = 0; m < 4; ++m) { const pg8::f32x4 v0 = acc[ai][bj][m][0], v1 = acc[ai][bj][m][1]; const u32x4 gg = g[bj][m]; u32x4 w;
                    w.x = pg8::cvt_pk_bf16(sigmoid_c80(bf_lo(gg.x)) * v0[0], sigmoid_c80(bf_hi(gg.x)) * v0[1]); w.y = pg8::cvt_pk_bf16(sigmoid_c80(bf_lo(gg.y)) * v0[2], sigmoid_c80(bf_hi(gg.y)) * v0[3]);
                    w.z = pg8::cvt_pk_bf16(sigmoid_c80(bf_lo(gg.z)) * v1[0], sigmoid_c80(bf_hi(gg.z)) * v1[1]); w.w = pg8::cvt_pk_bf16(sigmoid_c80(bf_lo(gg.w)) * v1[2], sigmoid_c80(bf_hi(gg.w)) * v1[3]);
                    *(u32x4*)(out + ro0 + (size_t)(ai * 128 + m * 16) * 1024 + bj * 128) = w; }
        }
    }
};
struct EpiGateB {
    static constexpr bool PERM = true, AFTER_DRAIN = false;
    const bf16* gate; const bf16* m1; bf16* out;
    __device__ __forceinline__ void operator()(const pg8::f32x4 (&acc)[2][2][4][2], const pg8::Unit& u, int wr, int wc, int fr, int fq) const {
        const size_t ro0 = (size_t)(u.pm * 256 + wr * 64 + fr) * 1024 + u.pn * 256 + wc * 32 + 8 * fq;
        u32x4 pk[2][2][4];
        pack_acc_half(pk[0], acc, 0); pack_acc_half(pk[1], acc, 1);
#pragma unroll
        for (int ai = 0; ai < 2; ++ai) {
            u32x4 g[2][4], p[2][4];
#pragma unroll
            for (int bj = 0; bj < 2; ++bj)
#pragma unroll
                for (int m = 0; m < 4; ++m) { const size_t ro = ro0 + (size_t)(ai * 128 + m * 16) * 1024 + bj * 128; g[bj][m] = *(const u32x4*)(gate + ro); p[bj][m] = *(const u32x4*)(m1 + ro); }
#pragma unroll
            for (int bj = 0; bj < 2; ++bj)
#pragma unroll
                for (int m = 0; m < 4; ++m) *(u32x4*)(out + ro0 + (size_t)(ai * 128 + m * 16) * 1024 + bj * 128) = gate8p_add(g[bj][m], p[bj][m], pk[ai][bj][m]);
        }
    }
};
struct EpiResid {
    static constexpr bool PERM = true, AFTER_DRAIN = false;
    const bf16* xb; bf16* x1b; float* ssq;
    __device__ __forceinline__ void operator()(const pg8::f32x4 (&acc)[2][2][4][2], const pg8::Unit& u, int wr, int wc, int fr, int fq) const {
        const int row0 = u.pm * 256 + wr * 64 + fr;
        const size_t ro0 = (size_t)row0 * 1024 + u.pn * 256 + wc * 32 + 8 * fq;
        u32x4 pk[2][2][4];
        pack_acc_half(pk[0], acc, 0); pack_acc_half(pk[1], acc, 1);
        u32x4 xq[2][2][4];
#pragma unroll
        for (int ai = 0; ai < 2; ++ai)
#pragma unroll
            for (int bj = 0; bj < 2; ++bj)
#pragma unroll
                for (int m = 0; m < 4; ++m) xq[ai][bj][m] = *(const u32x4*)(xb + ro0 + (size_t)(ai * 128 + m * 16) * 1024 + bj * 128);
#pragma unroll
        for (int ai = 0; ai < 2; ++ai)
#pragma unroll
            for (int m = 0; m < 4; ++m) {
                const int row = row0 + ai * 128 + m * 16;
                float ss = 0.f;
#pragma unroll
                for (int bj = 0; bj < 2; ++bj) {
                    const u32x4 xv = xq[ai][bj][m], a = pk[ai][bj][m];
                    u32x4 w; w.x = pk2(bf_lo(xv.x) + bf_lo(a.x), bf_hi(xv.x) + bf_hi(a.x)); w.y = pk2(bf_lo(xv.y) + bf_lo(a.y), bf_hi(xv.y) + bf_hi(a.y));
                    w.z = pk2(bf_lo(xv.z) + bf_lo(a.z), bf_hi(xv.z) + bf_hi(a.z)); w.w = pk2(bf_lo(xv.w) + bf_lo(a.w), bf_hi(xv.w) + bf_hi(a.w));
                    *(u32x4*)(x1b + ro0 + (size_t)(ai * 128 + m * 16) * 1024 + bj * 128) = w;
                    const float q0 = bf_lo(w.x), q1 = bf_hi(w.x), q2 = bf_lo(w.y), q3 = bf_hi(w.y), q4 = bf_lo(w.z), q5 = bf_hi(w.z), q6 = bf_lo(w.w), q7 = bf_hi(w.w);
                    ss += ((q0 * q0 + q1 * q1) + (q2 * q2 + q3 * q3)) + ((q4 * q4 + q5 * q5) + (q6 * q6 + q7 * q7));
                }
                ss += __shfl_xor(ss, 16); ss += __shfl_xor(ss, 32);
                if (fq == 0) ssq[(size_t)row * 16 + u.pn * 4 + wc] = ss;
            }
    }
};
typedef _Float16 f16x2_t __attribute__((ext_vector_type(2)));
struct EpiScore {
    static constexpr bool PERM = true, AFTER_DRAIN = false;
    const LAS float* rl; unsigned short* out; mutable int ord;
    __device__ __forceinline__ void operator()(const pg8::f32x4 (&acc)[2][2][4][2], const pg8::Unit& u, int wr, int wc, int fr, int fq) const {
        const int row0 = u.pm * 256 + wr * 64 + fr, col0 = u.pn * 256 + wc * 32 + 8 * fq;
        const LAS float* rp = rl + 256 * ord + wr * 64 + fr; ++ord;
#pragma unroll
        for (int ai = 0; ai < 2; ++ai)
#pragma unroll
            for (int m = 0; m < 4; ++m) {
                const int row = row0 + ai * 128 + m * 16;
                const float rstd = rp[ai * 128 + m * 16];
                const size_t ro = ((size_t)((row >> 6) * 8 + u.pn) * 32 + (wc * 4 + fq)) * 512 + (size_t)(row & 63) * 8;
#pragma unroll
                for (int bj = 0; bj < 2; ++bj) { const pg8::f32x4 v0 = acc[ai][bj][m][0] * rstd, v1 = acc[ai][bj][m][1] * rstd; u32x4 w;
                    w.x = __builtin_bit_cast(unsigned, __builtin_amdgcn_cvt_pkrtz(v0[0], v0[1])); w.y = __builtin_bit_cast(unsigned, __builtin_amdgcn_cvt_pkrtz(v0[2], v0[3]));
                    w.z = __builtin_bit_cast(unsigned, __builtin_amdgcn_cvt_pkrtz(v1[0], v1[1])); w.w = __builtin_bit_cast(unsigned, __builtin_amdgcn_cvt_pkrtz(v1[2], v1[3]));
                    *(u32x4*)(out + ro + bj * (16 * 512)) = w; }
            }
    }
};

typedef short bf16x8 __attribute__((ext_vector_type(8)));
typedef short s16x4 __attribute__((ext_vector_type(4)));
typedef short v4i16_t __attribute__((ext_vector_type(4)));
typedef float f32x16 __attribute__((ext_vector_type(16)));
#define MFMA32(a, b, c) __builtin_amdgcn_mfma_f32_32x32x16_bf16((a), (b), (c), 0, 0, 0)

__device__ __forceinline__ void p0_transpose_item(const float* W, int K, int N, bf16* WT, LAS float* scr, int item, int lane, int ld = 0) {
    if (ld == 0) ld = K;
    const int nblk = N / 32, kb = item / nblk, nb = item % nblk, k0 = 64 * kb, n0 = 32 * nb;
#pragma unroll 8
    for (int i = 0; i < 32; ++i) { const int kk = 2 * i + (lane >> 5); scr[kk * 33 + (lane & 31)] = W[(size_t)(k0 + kk) * N + n0 + (lane & 31)]; }
    asm volatile("s_waitcnt lgkmcnt(0)" ::: "memory");
    const int c = lane & 7;
#pragma unroll
    for (int j = 0; j < 4; ++j) { const int n = (lane >> 3) + 8 * j; const LAS float* s = scr + (8 * c) * 33 + n;
        u32x4 o; o.x = pk2(s[0 * 33], s[1 * 33]); o.y = pk2(s[2 * 33], s[3 * 33]); o.z = pk2(s[4 * 33], s[5 * 33]); o.w = pk2(s[6 * 33], s[7 * 33]);
        *(u32x4*)(WT + (size_t)(n0 + n) * ld + k0 + 8 * c) = o; }
    asm volatile("s_waitcnt lgkmcnt(0)" ::: "memory");
}
__device__ __forceinline__ void split_frag(const f32x4 a, const f32x4 b, bf16x8& hi, bf16x8& lo) {
    u32x4 ph, pl;
    ph.x = pk2(a.x, a.y); ph.y = pk2(a.z, a.w); ph.z = pk2(b.x, b.y); ph.w = pk2(b.z, b.w);
    pl.x = pk2(a.x - bf_lo(ph.x), a.y - bf_hi(ph.x)); pl.y = pk2(a.z - bf_lo(ph.y), a.w - bf_hi(ph.y));
    pl.z = pk2(b.x - bf_lo(ph.z), b.y - bf_hi(ph.z)); pl.w = pk2(b.z - bf_lo(ph.w), b.w - bf_hi(ph.w));
    hi = __builtin_bit_cast(bf16x8, ph); lo = __builtin_bit_cast(bf16x8, pl);
}
__device__ __forceinline__ void p0_wsc_item(const float* Wq, const float* keys, const float* g2, bf16* Wsc, int item, int lane) {
    const int nb = item & 3, kb = (item >> 2) & 31, g = item >> 7;
    const int r = lane & 31, h = lane >> 5;
    const float* ap = Wq + (size_t)(kb * 32 + r) * 2048 + g * 128 + 8 * h;
    const float* bp = keys + ((size_t)g * 128 + nb * 32 + r) * 128 + 8 * h;
    f32x16 d;
#pragma unroll
    for (int i = 0; i < 16; ++i) d[i] = 0.f;
#pragma unroll
    for (int ks = 0; ks < 8; ++ks) {
        bf16x8 ah, al, bh, bl;
        split_frag(*(const f32x4*)(ap + 16 * ks), *(const f32x4*)(ap + 16 * ks + 4), ah, al);
        split_frag(*(const f32x4*)(bp + 16 * ks), *(const f32x4*)(bp + 16 * ks + 4), bh, bl);
        d = MFMA32(ah, bh, d); d = MFMA32(ah, bl, d); d = MFMA32(al, bh, d);
    }
    bf16* op = Wsc + (size_t)(g * 128 + nb * 32 + r) * 1024 + kb * 32 + 4 * h;
    const float* gp = g2 + kb * 32 + 4 * h;
#pragma unroll
    for (int q = 0; q < 4; ++q) { const f32x4 gs = *(const f32x4*)(gp + 8 * q); u32x2 w;
        w.x = pk2(d[4 * q] * gs.x, d[4 * q + 1] * gs.y); w.y = pk2(d[4 * q + 2] * gs.z, d[4 * q + 3] * gs.w);
        *(u32x2*)(op + 8 * q) = w; }
}
__device__ __forceinline__ void row_load16(f32x4 (&v)[4], const float* xrow, int lane) {
    const f32x4* xr = (const f32x4*)xrow + lane;
#pragma unroll
    for (int j = 0; j < 4; ++j) v[j] = xr[64 * j];
}
__device__ __forceinline__ void rms_row_finish(const f32x4 (&v)[4], const float* g, bf16* orow, bf16* xbrow, int lane) {
    const f32x4* gr = (const f32x4*)g + lane;
    { unsigned long long* x8 = (unsigned long long*)xbrow + lane;
#pragma unroll
      for (int j = 0; j < 4; ++j) x8[64 * j] = (unsigned long long)pk2(v[j].x, v[j].y) | ((unsigned long long)pk2(v[j].z, v[j].w) << 32); }
    float s = 0.f;
#pragma unroll
    for (int j = 0; j < 4; ++j) s += (v[j].x * v[j].x + v[j].y * v[j].y) + (v[j].z * v[j].z + v[j].w * v[j].w);
    const float rstd = rsqrtf(wave_sum(s) * (1.f / D) + RMS_EPS);
    unsigned long long* o8 = (unsigned long long*)orow + lane;
#pragma unroll
    for (int j = 0; j < 4; ++j) { const f32x4 gv = gr[64 * j];
        o8[64 * j] = (unsigned long long)pk2(v[j].x * rstd * gv.x, v[j].y * rstd * gv.y) | ((unsigned long long)pk2(v[j].z * rstd * gv.z, v[j].w * rstd * gv.w) << 32); }
}

__device__ __forceinline__ s16x4 vtr(const LAS unsigned char* p) { return __builtin_bit_cast(s16x4, __builtin_amdgcn_ds_read_tr16_b64_v4i16((LAS v4i16_t*)p)); }
template <int S> __device__ __forceinline__ bf16x8 pack8(const f32x16& x) {
    u32x4 p; p.x = pk2(x[8 * S], x[8 * S + 1]); p.y = pk2(x[8 * S + 2], x[8 * S + 3]); p.z = pk2(x[8 * S + 4], x[8 * S + 5]); p.w = pk2(x[8 * S + 6], x[8 * S + 7]);
    return __builtin_bit_cast(bf16x8, p);
}
template <int S> __device__ __forceinline__ void split8(const f32x16& x, bf16x8& hi, bf16x8& lo) {
    u32x4 ph, pl;
#pragma unroll
    for (int j = 0; j < 4; ++j) {
        const unsigned hb = pk2(x[8 * S + 2 * j], x[8 * S + 2 * j + 1]);
        ph[j] = hb; pl[j] = pk2(x[8 * S + 2 * j] - bf_lo(hb), x[8 * S + 2 * j + 1] - bf_hi(hb));
    }
    hi = __builtin_bit_cast(bf16x8, ph); lo = __builtin_bit_cast(bf16x8, pl);
}
__device__ __forceinline__ void load_kfrag(bf16x8 (&kf)[4], const bf16* Kp, size_t row0, int lane) {
    const bf16* kp = Kp + (row0 + (lane & 31)) * 1024 + 8 * (lane >> 5);
#pragma unroll
    for (int ks = 0; ks < 4; ++ks) kf[ks] = *(const bf16x8*)(kp + 16 * ks);
}
__device__ __forceinline__ void load_vregs(u32x4 (&vr)[4], const bf16* Vp, size_t row0, int lane) {
#pragma unroll
    for (int i = 0; i < 4; ++i) { const int p = lane + 64 * i; vr[i] = *(const u32x4*)(Vp + (row0 + (p >> 3)) * 1024 + (p & 7) * 8); }
}
__device__ __forceinline__ void store_vlds(LAS unsigned char* vl, const u32x4 (&vr)[4], int lane) {
#pragma unroll
    for (int i = 0; i < 4; ++i) { const int p = lane + 64 * i; *(LAS u32x4*)(vl + (p >> 3) * 128 + (p & 7) * 16) = vr[i]; }
}
__device__ __forceinline__ void pv_block(f32x16 (&o)[2], const LAS unsigned char* vl, const bf16x8 p0, const bf16x8 p1, int lane) {
    const int i16 = lane & 15, h = lane >> 5;
    const unsigned base = (unsigned)(__UINTPTR_TYPE__)(vl + (4 * h + (i16 >> 2)) * 128 + (16 * ((lane >> 4) & 1) + 4 * (i16 & 3)) * 2);
    s16x4 t0, t1, t2, t3, t4, t5, t6, t7;
    asm volatile("ds_read_b64_tr_b16 %0, %8\n\tds_read_b64_tr_b16 %1, %8 offset:1024\n\tds_read_b64_tr_b16 %2, %8 offset:2048\n\tds_read_b64_tr_b16 %3, %8 offset:3072\n\t"
                 "ds_read_b64_tr_b16 %4, %8 offset:64\n\tds_read_b64_tr_b16 %5, %8 offset:1088\n\tds_read_b64_tr_b16 %6, %8 offset:2112\n\tds_read_b64_tr_b16 %7, %8 offset:3136\n\t"
                 "s_waitcnt lgkmcnt(0)"
                 : "=&v"(t0), "=&v"(t1), "=&v"(t2), "=&v"(t3), "=&v"(t4), "=&v"(t5), "=&v"(t6), "=&v"(t7) : "v"(base) : "memory");
    __builtin_amdgcn_sched_barrier(0);
    o[0] = MFMA32(__builtin_shufflevector(t0, t1, 0, 1, 2, 3, 4, 5, 6, 7), p0, o[0]);
    o[0] = MFMA32(__builtin_shufflevector(t2, t3, 0, 1, 2, 3, 4, 5, 6, 7), p1, o[0]);
    o[1] = MFMA32(__builtin_shufflevector(t4, t5, 0, 1, 2, 3, 4, 5, 6, 7), p0, o[1]);
    o[1] = MFMA32(__builtin_shufflevector(t6, t7, 0, 1, 2, 3, 4, 5, 6, 7), p1, o[1]);
}
__device__ __forceinline__ void store_ot(const f32x16 (&o)[2], float sc, bf16* op, int h) {
#pragma unroll
    for (int db = 0; db < 2; ++db)
#pragma unroll
        for (int g = 0; g < 4; ++g) { u32x2 w; w.x = pk2(o[db][4 * g] * sc, o[db][4 * g + 1] * sc); w.y = pk2(o[db][4 * g + 2] * sc, o[db][4 * g + 3] * sc);
            *(u32x2*)(op + 32 * db + 8 * g + 4 * h) = w; }
}
constexpr int ATT_SLOT = 16384, ATT_NSLOT = 4, ATT_RING = ATT_NSLOT * ATT_SLOT, ATT_FLAGS = ATT_RING;
__device__ __forceinline__ void att_dma(LAS unsigned char* slot, const bf16* Kp, const bf16* Vp, size_t row0, int wave, int lane) {
    const int r = 8 * (wave & 3) + (lane >> 3), p = lane & 7;
    const bf16* src = (wave < 4) ? Kp + (row0 + r) * 1024 + ((p ^ ((r >> 1) & 7)) * 8) : Vp + (row0 + r) * 1024 + p * 8;
    __builtin_amdgcn_global_load_lds((const unsigned*)src, (LAS unsigned*)(slot + wave * 1024), 16, 0, 0);
}
__device__ __forceinline__ void load_kfrag_lds(bf16x8 (&kf)[4], const LAS unsigned char* kt, int lane) {
    const int r = lane & 31, h = lane >> 5, f = (r >> 1) & 7;
#pragma unroll
    for (int ks = 0; ks < 4; ++ks) kf[ks] = *(const LAS bf16x8*)(kt + r * 128 + (((2 * ks + h) ^ f) * 16));
}
#define ATT_WAIT(n) asm volatile("s_waitcnt vmcnt(" #n ")" ::: "memory")
__device__ __forceinline__ void att_wait(int ahead) {
    if (ahead >= 2) ATT_WAIT(4); else if (ahead == 1) ATT_WAIT(2); else ATT_WAIT(0);
}
__device__ __forceinline__ void att_dma2(LAS unsigned char* slot, const bf16* Kp, const bf16* Vp, size_t row0, int wave, int lane) {
    att_dma(slot, Kp, Vp, row0, wave, lane); att_dma(slot + 8192, Kp, Vp, row0 + 32, wave, lane);
}
__device__ __forceinline__ void att_bar() { asm volatile("s_waitcnt lgkmcnt(0)" ::: "memory"); __builtin_amdgcn_s_barrier(); asm volatile("" ::: "memory"); }

__device__ __forceinline__ f32x16 qk_block(const LAS unsigned char* blk, const bf16x8 (&qf)[4], int lane) {
    bf16x8 kf[4]; load_kfrag_lds(kf, blk, lane);
    f32x16 s;
#pragma unroll
    for (int i = 0; i < 16; ++i) s[i] = 0.f;
#pragma unroll
    for (int ks = 0; ks < 4; ++ks) s = MFMA32(kf[ks], qf[ks], s);
    return s;
}
__device__ __forceinline__ bool sb_block(f32x16 s, const LAS unsigned char* blk, const bf16x8 (&tri)[2], f32x16 (&o)[2], float& c2, bool diag, int c, int h, int lane) {
    f32x16 L;
#pragma unroll
    for (int i = 0; i < 16; ++i) {
        const float z = s[i] * QSCALE;
        const float sp = fmaxf(z, 0.f) + flog2(1.f + fexp2(-fabsf(z)));
        const bool valid = !diag || ((i & 3) + 8 * (i >> 2) + 4 * h) < c;
        L[i] = valid ? -sp : 0.f;
        s[i] = valid ? z : -1e30f;
    }
    bf16x8 h0, l0, h1, l1;
    split8<0>(L, h0, l0); split8<1>(L, h1, l1);
    f32x16 suf;
#pragma unroll
    for (int i = 0; i < 16; ++i) suf[i] = 0.f;
    suf = MFMA32(tri[0], h0, suf); suf = MFMA32(tri[1], h1, suf); suf = MFMA32(tri[0], l0, suf); suf = MFMA32(tri[1], l1, suf);
#pragma unroll
    for (int i = 0; i < 16; ++i) s[i] = fexp2(s[i] + suf[i] + c2);
    pv_block(o, blk + 4096, pack8<0>(s), pack8<1>(s), lane);
    c2 += __shfl(suf[0], c);
    return __all(c2 < -64.f) != 0;
}
__device__ __forceinline__ void sb_wg_unit(int unit, LAS unsigned char* lds, const bf16* QK, const bf16* Vb, bf16* Osb, int wave, int lane) {
    const int qs = unit & 31, hd = (unit >> 5) & 7, b = unit >> 8;
    const int Q0 = qs * 256, q0 = Q0 + 32 * wave, c = lane & 31, h = lane >> 5;
    const size_t rowbase = (size_t)b * SEQ;
    const bf16* Kp = QK + 512 + hd * 64; const bf16* Vp = Vb + hd * 64;
    LAS unsigned* flags = (LAS unsigned*)(lds + ATT_FLAGS);
    bf16x8 qf[4];
    { const bf16* qp = QK + (rowbase + q0 + c) * 1024 + hd * 64 + 8 * h;
#pragma unroll
      for (int ks = 0; ks < 4; ++ks) qf[ks] = *(const bf16x8*)(qp + 16 * ks);
      asm volatile("" :: "v"(qf[0]), "v"(qf[1]), "v"(qf[2]), "v"(qf[3])); }
    att_bar();
    if (lane < 2) flags[lane * 8 + wave] = 0u;
    bf16x8 tri[2];
#pragma unroll
    for (int ks = 0; ks < 2; ++ks)
#pragma unroll
        for (int j = 0; j < 8; ++j) tri[ks][j] = (16 * ks + 8 * (j >> 2) + 4 * h + (j & 3) >= c) ? (short)0x3F80 : (short)0;
    f32x16 o[2];
#pragma unroll
    for (int i = 0; i < 16; ++i) { o[0][i] = 0.f; o[1][i] = 0.f; }
    float c2 = 0.f; bool mydone = false;
    const int Jmin = -(Q0 >> 6);
    att_bar();
    int slot = 0;
#pragma unroll
    for (int d = 0; d < 3; ++d) if (3 - d >= Jmin) att_dma2(lds + d * ATT_SLOT, Kp, Vp, rowbase + Q0 + 64 * (3 - d), wave, lane);
    for (int J = 3; J >= Jmin; --J) {
        att_wait(J - Jmin < 2 ? J - Jmin : 2);
        att_bar();
        const LAS unsigned* fr = flags + ((J + 1) & 1) * 8;
        const u32x4 f0 = *(const LAS u32x4*)fr, f1 = *(const LAS u32x4*)(fr + 4);
        if (J < 3 && (f0.x & f0.y & f0.z & f0.w & f1.x & f1.y & f1.z & f1.w) != 0u) break;
        const LAS unsigned char* img = lds + slot * ATT_SLOT;
        const int sprev = slot == 0 ? ATT_NSLOT - 1 : slot - 1;
        if (J - 3 >= Jmin) att_dma2(lds + sprev * ATT_SLOT, Kp, Vp, rowbase + Q0 + 64 * (J - 3), wave, lane);
        if (!mydone && 2 * J <= wave) {
            const bool hi_on = 2 * J + 1 <= wave;
            f32x16 s_hi, s_lo = qk_block(img, qf, lane);
            if (hi_on) { s_hi = qk_block(img + 8192, qf, lane); mydone = sb_block(s_hi, img + 8192, tri, o, c2, 2 * J + 1 == wave, c, h, lane); }
            if (!mydone) mydone = sb_block(s_lo, img, tri, o, c2, 2 * J == wave, c, h, lane);
        }
        if (lane == 0) flags[(J & 1) * 8 + wave] = mydone ? 1u : 0u;
        slot = slot + 1 == ATT_NSLOT ? 0 : slot + 1;
    }
    ATT_WAIT(0);
    store_ot(o, 1.f, Osb + (rowbase + q0 + c) * 1024 + hd * 64, h);
}
__device__ __forceinline__ void ca_block(f32x16 s, const LAS unsigned char* blk, f32x16 (&o)[2], float& m, float& l, const LAS float* bh, int key0, int q0, int c, int h, int lane) {
    const bool cbias = key0 <= q0 - 159;
    float bc = 0.f;
    if (cbias) bc = bh[128];
    else {
        const int relb = q0 + c - key0 - 4 * h;
#pragma unroll
        for (int i = 0; i < 16; ++i) { int rel = relb - ((i & 3) + 8 * (i >> 2)); rel = rel < -128 ? -128 : (rel > 128 ? 128 : rel); s[i] = s[i] + bh[rel] * (1.f / QSCALE); }
    }
    float bm = s[0];
#pragma unroll
    for (int i = 1; i < 16; ++i) bm = fmaxf(bm, s[i]);
    bm = fmaxf(bm, __shfl_xor(bm, 32)) * QSCALE + bc;
    const float mn = fmaxf(m, bm);
    if (__any(mn - m > 8.f)) {
        const float alpha = fexp2(m - mn); l *= alpha; m = mn;
#pragma unroll
        for (int i = 0; i < 16; ++i) { o[0][i] *= alpha; o[1][i] *= alpha; }
    }
    const float off = bc - m;
#pragma unroll
    for (int i = 0; i < 16; ++i) s[i] = fexp2(s[i] * QSCALE + off);
    const bf16x8 p0 = pack8<0>(s), p1 = pack8<1>(s);
    { const u32x4 a = __builtin_bit_cast(u32x4, p0), b = __builtin_bit_cast(u32x4, p1); float ps = 0.f;
      ps = dot2bf(a.x, 0x3F803F80u, ps); ps = dot2bf(a.y, 0x3F803F80u, ps); ps = dot2bf(a.z, 0x3F803F80u, ps); ps = dot2bf(a.w, 0x3F803F80u, ps);
      ps = dot2bf(b.x, 0x3F803F80u, ps); ps = dot2bf(b.y, 0x3F803F80u, ps); ps = dot2bf(b.z, 0x3F803F80u, ps); ps = dot2bf(b.w, 0x3F803F80u, ps);
      l += ps; }
    pv_block(o, blk + 4096, p0, p1, lane);
}
__device__ __forceinline__ void ca_wg_unit(int unit, LAS unsigned char* lds, const LAS float* biasl, const bf16* Qc, const bf16* KVc, bf16* Oca, int wave, int lane) {
    const int qs = unit & 31, hd = (unit >> 5) & 7, b = unit >> 8;
    const int Q0 = qs * 256, q0 = Q0 + 32 * wave, c = lane & 31, h = lane >> 5;
    const size_t rowbase = (size_t)b * SEQ;
    const bf16* Kp = KVc + hd * 64; const bf16* Vp = KVc + 512 + hd * 64;
    bf16x8 qf[4];
    { const bf16* qp = Qc + (rowbase + q0 + c) * 1024 + 512 + hd * 64 + 8 * h;
#pragma unroll
      for (int ks = 0; ks < 4; ++ks) qf[ks] = *(const bf16x8*)(qp + 16 * ks);
      asm volatile("" :: "v"(qf[0]), "v"(qf[1]), "v"(qf[2]), "v"(qf[3])); }
    const LAS float* bh = biasl + hd * 257 + 128;
    f32x16 o[2];
#pragma unroll
    for (int i = 0; i < 16; ++i) { o[0][i] = 0.f; o[1][i] = 0.f; }
    float m = -1e30f, l = 0.f;
    const int kb0 = (Q0 >= 512) ? 0 : (512 - Q0) / 64, wlo = wave >> 1;
    const long kbase = (long)rowbase + Q0 - 512;
    att_bar();
    int slot = 0;
#pragma unroll
    for (int d = 0; d < 3; ++d) att_dma2(lds + d * ATT_SLOT, Kp, Vp, (size_t)(kbase + 64 * (kb0 + d)), wave, lane);
    for (int kb = kb0; kb < 12; ++kb) {
        att_wait(11 - kb < 2 ? 11 - kb : 2);
        att_bar();
        const LAS unsigned char* img = lds + slot * ATT_SLOT;
        const int sprev = slot == 0 ? ATT_NSLOT - 1 : slot - 1;
        if (kb + 3 < 12) att_dma2(lds + sprev * ATT_SLOT, Kp, Vp, (size_t)(kbase + 64 * (kb + 3)), wave, lane);
        if (kb >= wlo && kb < wlo + 9) {
            const f32x16 sa = qk_block(img, qf, lane), sb = qk_block(img + 8192, qf, lane);
            ca_block(sa, img, o, m, l, bh, Q0 - 512 + 64 * kb, q0, c, h, lane);
            ca_block(sb, img + 8192, o, m, l, bh, Q0 - 512 + 64 * kb + 32, q0, c, h, lane);
        }
        slot = slot + 1 == ATT_NSLOT ? 0 : slot + 1;
    }
    l += __shfl_xor(l, 32);
    store_ot(o, 1.f / l, Oca + (rowbase + q0 + c) * 1024 + hd * 64, h);
}

#define CE(x, y) do { const float hi_ = fmaxf(x, y); y = fminf(x, y); x = hi_; } while (0)
#define SORT16(a) do { CE(a[0], a[1]); CE(a[2], a[3]); CE(a[0], a[2]); CE(a[1], a[3]); CE(a[1], a[2]); CE(a[4], a[5]); CE(a[6], a[7]); CE(a[4], a[6]); CE(a[5], a[7]); CE(a[5], a[6]); CE(a[0], a[4]); CE(a[2], a[6]); CE(a[2], a[4]); CE(a[1], a[5]); CE(a[3], a[7]); CE(a[3], a[5]); CE(a[1], a[2]); CE(a[3], a[4]); CE(a[5], a[6]); CE(a[8], a[9]); CE(a[10], a[11]); CE(a[8], a[10]); CE(a[9], a[11]); CE(a[9], a[10]); CE(a[12], a[13]); CE(a[14], a[15]); CE(a[12], a[14]); CE(a[13], a[15]); CE(a[13], a[14]); CE(a[8], a[12]); CE(a[10], a[14]); CE(a[10], a[12]); CE(a[9], a[13]); CE(a[11], a[15]); CE(a[11], a[13]); CE(a[9], a[10]); CE(a[11], a[12]); CE(a[13], a[14]); CE(a[0], a[8]); CE(a[4], a[12]); CE(a[4], a[8]); CE(a[2], a[10]); CE(a[6], a[14]); CE(a[6], a[10]); CE(a[2], a[4]); CE(a[6], a[8]); CE(a[10], a[12]); CE(a[1], a[9]); CE(a[5], a[13]); CE(a[5], a[9]); CE(a[3], a[11]); CE(a[7], a[15]); CE(a[7], a[11]); CE(a[3], a[5]); CE(a[7], a[9]); CE(a[11], a[13]); CE(a[1], a[2]); CE(a[3], a[4]); CE(a[5], a[6]); CE(a[7], a[8]); CE(a[9], a[10]); CE(a[11], a[12]); CE(a[13], a[14]); } while (0)
#define BMERGE16(a) do { CE(a[0], a[8]); CE(a[1], a[9]); CE(a[2], a[10]); CE(a[3], a[11]); CE(a[4], a[12]); CE(a[5], a[13]); CE(a[6], a[14]); CE(a[7], a[15]); CE(a[0], a[4]); CE(a[1], a[5]); CE(a[2], a[6]); CE(a[3], a[7]); CE(a[8], a[12]); CE(a[9], a[13]); CE(a[10], a[14]); CE(a[11], a[15]); CE(a[0], a[2]); CE(a[1], a[3]); CE(a[4], a[6]); CE(a[5], a[7]); CE(a[8], a[10]); CE(a[9], a[11]); CE(a[12], a[14]); CE(a[13], a[15]); CE(a[0], a[1]); CE(a[2], a[3]); CE(a[4], a[5]); CE(a[6], a[7]); CE(a[8], a[9]); CE(a[10], a[11]); CE(a[12], a[13]); CE(a[14], a[15]); } while (0)

__device__ __forceinline__ void keys16(float (&N)[16], const u32x4 a, const u32x4 b, int base) {
    const unsigned w[8] = {a.x, a.y, a.z, a.w, b.x, b.y, b.z, b.w};
#pragma unroll
    for (int i = 0; i < 8; ++i) { N[2 * i] = __uint_as_float((w[i] << 16) | (unsigned)(base + 2 * i)); N[2 * i + 1] = __uint_as_float((w[i] & 0xffff0000u) | (unsigned)(base + 2 * i + 1)); }
}
__device__ __forceinline__ void top16_of_128(float (&L)[16], const unsigned short* p) {
    u32x4 va[8], vb[8];
#pragma unroll
    for (int i = 0; i < 8; ++i) va[i] = *(const u32x4*)(p + 512 * i);
#pragma unroll
    for (int i = 0; i < 8; ++i) vb[i] = *(const u32x4*)(p + 512 * (8 + i));
    float N[16];
    keys16(L, va[0], va[1], 0); SORT16(L);
#pragma unroll
    for (int ch = 1; ch < 8; ++ch) {
        if (ch < 4) keys16(N, va[2 * ch], va[2 * ch + 1], 16 * ch); else keys16(N, vb[2 * ch - 8], vb[2 * ch - 7], 16 * ch);
        SORT16(N);
#pragma unroll
        for (int k = 0; k < 16; ++k) L[k] = fmaxf(L[k], N[15 - k]);
        BMERGE16(L);
    }
}
__device__ __forceinline__ float f16bits_to_f32(unsigned h) { return (float)__builtin_bit_cast(_Float16, (unsigned short)h); }
__device__ __forceinline__ void topk_task(int task, const unsigned short* scores, int* idx_out, float* g_out, LAS int* scr, int lane) {
    const int tb = task >> 3, h = task & 7; const int t = tb * 64 + lane;
    const unsigned short* sp = scores + (size_t)(tb * 8 + h) * (32 * 512) + lane * 8;
    float A[16], B[16];
    top16_of_128(A, sp);
    top16_of_128(B, sp + 16 * 512);
    float av[16], bv[16];
#pragma unroll
    for (int k = 0; k < 16; ++k) { const unsigned ua = __float_as_uint(A[k]), ub = __float_as_uint(B[k]);
        av[k] = f16bits_to_f32(ua >> 16); bv[k] = f16bits_to_f32(ub >> 16);
        scr[k * 64 + lane] = (int)(ua & 0x7fu) * 128; scr[(16 + k) * 64 + lane] = (int)(ub & 0x7fu); }
    const float NINF = -__builtin_inff();
    float lv[16];
#pragma unroll
    for (int k = 0; k < 16; ++k) lv[k] = NINF;
#pragma unroll
    for (int i = 0; i < 16; ++i)
#pragma unroll
        for (int j = 0; j < 16; ++j)
            if ((i + 1) * (j + 1) <= 16) {
                float x = __uint_as_float((__float_as_uint(av[i] + bv[j]) & 0xffffff00u) | (unsigned)(16 * i + j));
#pragma unroll
                for (int k = (i + 1) * (j + 1) - 1; k < 16; ++k) { const float hi = fmaxf(lv[k], x); x = fminf(lv[k], x); lv[k] = hi; }
            }
    float e[16]; int li[16]; float sum = 0.f;
    const float v0 = __uint_as_float(__float_as_uint(lv[0]) & 0xffffff00u);
#pragma unroll
    for (int k = 0; k < 16; ++k) { const unsigned u = __float_as_uint(lv[k]); const int ci = (u >> 4) & 15, cj = u & 15;
        li[k] = scr[ci * 64 + lane] + scr[(16 + cj) * 64 + lane];
        e[k] = fexp2((__uint_as_float(u & 0xffffff00u) - v0) * LOG2E); sum += e[k]; }
    const float inv = 1.f / sum;
    int* io = idx_out + (size_t)t * 128 + h * 16; float* go = g_out + (size_t)t * 128 + h * 16;
#pragma unroll
    for (int k = 0; k < 16; k += 4) { *(int4*)(io + k) = make_int4(li[k], li[k + 1], li[k + 2], li[k + 3]);
        *(f32x4*)(go + k) = (f32x4){e[k] * inv, e[k + 1] * inv, e[k + 2] * inv, e[k + 3] * inv}; }
}

constexpr int P7_NS = 4, P7_SLICE_BYTES = 16384 * 128, P7_WPS = 512;
__device__ __forceinline__ float wave_max(float v) {
#pragma unroll
    for (int o = 1; o < 64; o <<= 1) v = fmaxf(v, __shfl_xor(v, o));
    return v;
}
__device__ __forceinline__ unsigned pack8_fp4(const f32x4 a, const f32x4 b, float inv) {
    unsigned p = 0;
    p = __builtin_amdgcn_cvt_scalef32_pk_fp4_f32(p, a.x * inv, a.y * inv, 1.0f, 0); p = __builtin_amdgcn_cvt_scalef32_pk_fp4_f32(p, a.z * inv, a.w * inv, 1.0f, 1);
    p = __builtin_amdgcn_cvt_scalef32_pk_fp4_f32(p, b.x * inv, b.y * inv, 1.0f, 2); p = __builtin_amdgcn_cvt_scalef32_pk_fp4_f32(p, b.z * inv, b.w * inv, 1.0f, 3);
    return p;
}
__device__ __forceinline__ void fp8_row_load(f32x4 (&v)[4], const float* src, int lane) {
    const f32x4* sp = (const f32x4*)src + 4 * lane;
#pragma unroll
    for (int j = 0; j < 4; ++j) v[j] = sp[j];
}
__device__ __forceinline__ void fp8_row_finish(f32x4 (&v)[4], const float* colscale, unsigned char* dst, float* scale_out, int lane) {
    float am = 0.f;
#pragma unroll
    for (int j = 0; j < 4; ++j) { if (colscale) v[j] = v[j] * ((const f32x4*)colscale)[4 * lane + j];
        am = fmaxf(am, fmaxf(fmaxf(fabsf(v[j].x), fabsf(v[j].y)), fmaxf(fabsf(v[j].z), fabsf(v[j].w)))); }
    am = wave_max(am);
    const float sc = am > 0.f ? am * (1.f / 6.f) : 1.f, inv = 1.f / sc;
    u32x2 o; o.x = pack8_fp4(v[0], v[1], inv); o.y = pack8_fp4(v[2], v[3], inv);
    *(u32x2*)(dst + (size_t)(lane >> 4) * P7_SLICE_BYTES + 8 * (lane & 15)) = o;
    if (lane == 0) *scale_out = sc;
}
__device__ __forceinline__ unsigned pack8_i4(const f32x4 a, const f32x4 b, float inv) {
    const float MAGIC = 12582912.f;
    const unsigned n0 = __float_as_uint(a.x * inv + MAGIC) & 15u, n1 = __float_as_uint(a.y * inv + MAGIC) & 15u, n2 = __float_as_uint(a.z * inv + MAGIC) & 15u, n3 = __float_as_uint(a.w * inv + MAGIC) & 15u;
    const unsigned n4 = __float_as_uint(b.x * inv + MAGIC) & 15u, n5 = __float_as_uint(b.y * inv + MAGIC) & 15u, n6 = __float_as_uint(b.z * inv + MAGIC) & 15u, n7 = __float_as_uint(b.w * inv + MAGIC) & 15u;
    return (n0 | (n4 << 4)) | ((n1 | (n5 << 4)) << 8) | ((n2 | (n6 << 4)) << 16) | ((n3 | (n7 << 4)) << 24);
}
__device__ __forceinline__ void int4_row_finish(f32x4 (&v)[4], const float* colscale, unsigned char* dst, float* scale_out, int lane) {
    float am = 0.f;
#pragma unroll
    for (int j = 0; j < 4; ++j) { if (colscale) v[j] = v[j] * ((const f32x4*)colscale)[4 * lane + j];
        am = fmaxf(am, fmaxf(fmaxf(fabsf(v[j].x), fabsf(v[j].y)), fmaxf(fabsf(v[j].z), fabsf(v[j].w)))); }
    am = wave_max(am);
    const float sc = am > 0.f ? am * (1.f / 7.f) : 1.f, inv = 1.f / sc;
    u32x2 o; o.x = pack8_i4(v[0], v[1], inv); o.y = pack8_i4(v[2], v[3], inv);
    *(u32x2*)(dst + (size_t)(lane >> 4) * P7_SLICE_BYTES + 8 * (lane & 15)) = o;
    if (lane == 0) *scale_out = sc;
}
#define FP4PAIR(w, sel) __builtin_amdgcn_cvt_scalef32_pk_f32_fp4((w), 1.0f, (sel))
__device__ __forceinline__ float dot32_fp4(const u32x4 r, const f32x2 (&h)[16]) {
    f32x2 s0 = FP4PAIR(r.x, 0) * h[0], s1 = FP4PAIR(r.x, 1) * h[1];
    s0 = __builtin_elementwise_fma(FP4PAIR(r.x, 2), h[2], s0); s1 = __builtin_elementwise_fma(FP4PAIR(r.x, 3), h[3], s1);
    s0 = __builtin_elementwise_fma(FP4PAIR(r.y, 0), h[4], s0); s1 = __builtin_elementwise_fma(FP4PAIR(r.y, 1), h[5], s1);
    s0 = __builtin_elementwise_fma(FP4PAIR(r.y, 2), h[6], s0); s1 = __builtin_elementwise_fma(FP4PAIR(r.y, 3), h[7], s1);
    s0 = __builtin_elementwise_fma(FP4PAIR(r.z, 0), h[8], s0); s1 = __builtin_elementwise_fma(FP4PAIR(r.z, 1), h[9], s1);
    s0 = __builtin_elementwise_fma(FP4PAIR(r.z, 2), h[10], s0); s1 = __builtin_elementwise_fma(FP4PAIR(r.z, 3), h[11], s1);
    s0 = __builtin_elementwise_fma(FP4PAIR(r.w, 0), h[12], s0); s1 = __builtin_elementwise_fma(FP4PAIR(r.w, 1), h[13], s1);
    s0 = __builtin_elementwise_fma(FP4PAIR(r.w, 2), h[14], s0); s1 = __builtin_elementwise_fma(FP4PAIR(r.w, 3), h[15], s1);
    s0 = s0 + s1;
    return s0.x + s0.y;
}
__device__ __forceinline__ void axpy32_fp4(f32x2 (&o)[16], float c, const u32x4 r) {
    const f32x2 cc = (f32x2){c, c};
    o[0] = __builtin_elementwise_fma(cc, FP4PAIR(r.x, 0), o[0]); o[1] = __builtin_elementwise_fma(cc, FP4PAIR(r.x, 1), o[1]); o[2] = __builtin_elementwise_fma(cc, FP4PAIR(r.x, 2), o[2]); o[3] = __builtin_elementwise_fma(cc, FP4PAIR(r.x, 3), o[3]);
    o[4] = __builtin_elementwise_fma(cc, FP4PAIR(r.y, 0), o[4]); o[5] = __builtin_elementwise_fma(cc, FP4PAIR(r.y, 1), o[5]); o[6] = __builtin_elementwise_fma(cc, FP4PAIR(r.y, 2), o[6]); o[7] = __builtin_elementwise_fma(cc, FP4PAIR(r.y, 3), o[7]);
    o[8] = __builtin_elementwise_fma(cc, FP4PAIR(r.z, 0), o[8]); o[9] = __builtin_elementwise_fma(cc, FP4PAIR(r.z, 1), o[9]); o[10] = __builtin_elementwise_fma(cc, FP4PAIR(r.z, 2), o[10]); o[11] = __builtin_elementwise_fma(cc, FP4PAIR(r.z, 3), o[11]);
    o[12] = __builtin_elementwise_fma(cc, FP4PAIR(r.w, 0), o[12]); o[13] = __builtin_elementwise_fma(cc, FP4PAIR(r.w, 1), o[13]); o[14] = __builtin_elementwise_fma(cc, FP4PAIR(r.w, 2), o[14]); o[15] = __builtin_elementwise_fma(cc, FP4PAIR(r.w, 3), o[15]);
}
__device__ __forceinline__ float swap_add32(float x, float y) { const auto r = __builtin_amdgcn_permlane32_swap(__float_as_uint(x), __float_as_uint(y), false, false); return __uint_as_float(r[0]) + __uint_as_float(r[1]); }
__device__ __forceinline__ float swap_add16(float x, float y) { const auto r = __builtin_amdgcn_permlane16_swap(__float_as_uint(x), __float_as_uint(y), false, false); return __uint_as_float(r[0]) + __uint_as_float(r[1]); }
__device__ __forceinline__ float dpp_ror8(float v) { return __int_as_float(__builtin_amdgcn_mov_dpp(__float_as_int(v), 0x128, 0xf, 0xf, true)); }
__device__ __forceinline__ void reduce32x8(const float (&d)[32], int lane, float (&r)[4]) {
    const bool b3 = (lane & 8) != 0;
    float k16[16], k8[8];
#pragma unroll
    for (int i = 0; i < 16; ++i) k16[i] = swap_add32(d[i], d[16 + i]);
#pragma unroll
    for (int i = 0; i < 8; ++i) k8[i] = swap_add16(k16[i], k16[8 + i]);
#pragma unroll
    for (int i = 0; i < 4; ++i) { const float keep = b3 ? k8[4 + i] : k8[i], send = b3 ? k8[i] : k8[4 + i]; r[i] = keep + dpp_ror8(send); }
}
__device__ __forceinline__ constexpr int rev3(int e) { return ((e & 1) << 2) | (e & 2) | ((e >> 2) & 1); }
__device__ __forceinline__ float reduce8x8(const float (&d)[8], int lane) {
    const bool b0 = (lane & 1) != 0, b1 = (lane & 2) != 0, b2 = (lane & 4) != 0;
    float k4[4], k2[2];
#pragma unroll
    for (int i = 0; i < 4; ++i) { const float keep = b0 ? d[4 + i] : d[i], send = b0 ? d[i] : d[4 + i]; k4[i] = keep + __shfl_xor(send, 1); }
#pragma unroll
    for (int i = 0; i < 2; ++i) { const float keep = b1 ? k4[2 + i] : k4[i], send = b1 ? k4[i] : k4[2 + i]; k2[i] = keep + __shfl_xor(send, 2); }
    const float keep = b2 ? k2[1] : k2[0], send = b2 ? k2[0] : k2[1];
    return keep + __shfl_xor(send, 4);
}
__device__ __forceinline__ void p7_load_idx(int (&ex)[8], const int* idx, int t, int half, int e8) {
    const int4* p = (const int4*)(idx + (size_t)t * 128 + 16 * e8 + 8 * half);
    const int4 v0 = p[0], v1 = p[1];
    ex[0] = v0.x; ex[1] = v0.y; ex[2] = v0.z; ex[3] = v0.w; ex[4] = v1.x; ex[5] = v1.y; ex[6] = v1.z; ex[7] = v1.w;
}
__device__ __forceinline__ void p7_issue_rows(u32x4 (&r)[8], const unsigned char* tab, const int (&ex)[8], int boff) {
#pragma unroll
    for (int j = 0; j < 8; ++j) r[j] = *(const u32x4*)(tab + (unsigned)((ex[j] << 7) + boff));
}
template <int CTRL> __device__ __forceinline__ int dpp_i(int v) { return __builtin_amdgcn_mov_dpp(v, CTRL, 0xf, 0xf, true); }
template <int CTRL> __device__ __forceinline__ float dpp_f(float v) { return __int_as_float(__builtin_amdgcn_mov_dpp(__float_as_int(v), CTRL, 0xf, 0xf, true)); }
struct P7aState { unsigned ix[4]; u32x4 r[2][8]; u32x2 x; };
struct P7aX { unsigned hn[4], ln[4]; float sx; };
struct P7aLaneK { unsigned sh_h, mask_h, sh_l, mask_l, xor_l; };
__device__ __forceinline__ float wave_max_fast(float v) {
    v = fmaxf(v, dpp_f<0xB1>(v)); v = fmaxf(v, dpp_f<0x4E>(v)); v = fmaxf(v, dpp_f<0x141>(v)); v = fmaxf(v, dpp_f<0x140>(v));
    { const auto r = __builtin_amdgcn_permlane16_swap(__float_as_uint(v), __float_as_uint(v), false, false); v = fmaxf(__uint_as_float(r[0]), __uint_as_float(r[1])); }
    { const auto r = __builtin_amdgcn_permlane32_swap(__float_as_uint(v), __float_as_uint(v), false, false); v = fmaxf(__uint_as_float(r[0]), __uint_as_float(r[1])); }
    return v;
}
__device__ __forceinline__ void p7a_quant_x(P7aX& q, const u32x2 x, const P7aLaneK& k, LAS unsigned* xb, int lane) {
    const float f0 = bf_lo(x.x), f1 = bf_hi(x.x), f2 = bf_lo(x.y), f3 = bf_hi(x.y);
    const float am = wave_max_fast(fmaxf(fmaxf(fabsf(f0), fabsf(f1)), fmaxf(fabsf(f2), fabsf(f3))));
    const float sx = am > 0.f ? am * (1.f / 119.f) : 1.f, inv = __builtin_amdgcn_rcpf(sx), MAGIC8 = 12582912.f + 8.f;
    const unsigned b0 = __float_as_uint(f0 * inv + MAGIC8), b1 = __float_as_uint(f1 * inv + MAGIC8), b2 = __float_as_uint(f2 * inv + MAGIC8), b3 = __float_as_uint(f3 * inv + MAGIC8);
    const unsigned P = __builtin_amdgcn_perm(b1, b0, 0x0c0c0400u) | __builtin_amdgcn_perm(b3, b2, 0x04000c0cu);
    const unsigned hp = (P >> k.sh_h) & k.mask_h;
    const unsigned lp = ((P << k.sh_l) & k.mask_l) ^ k.xor_l;
    const unsigned hn = hp | (unsigned)dpp_i<0xB1>((int)hp), ln = lp | (unsigned)dpp_i<0xB1>((int)lp);
    xb[lane >> 1] = hn; xb[32 + (lane >> 1)] = ln;
    const u32x4 h = *(const LAS u32x4*)(xb + 4 * (lane & 7)), l = *(const LAS u32x4*)(xb + 32 + 4 * (lane & 7));
    q.hn[0] = h.x; q.hn[1] = h.y; q.hn[2] = h.z; q.hn[3] = h.w; q.ln[0] = l.x; q.ln[1] = l.y; q.ln[2] = l.z; q.ln[3] = l.w;
    q.sx = sx;
}
__device__ __forceinline__ int dot8z(unsigned a, unsigned b) { int d; asm("v_dot8_i32_i4 %0, %1, %2, 0" : "=v"(d) : "v"(a), "v"(b)); return d; }
__device__ __forceinline__ int dot32_i4(const u32x4 r, const P7aX& q) {
    int dh = dot8z(r.x, q.hn[0]), dl = dot8z(r.x, q.ln[0]);
    dh = __builtin_amdgcn_sdot8((int)r.y, (int)q.hn[1], dh, false); dl = __builtin_amdgcn_sdot8((int)r.y, (int)q.ln[1], dl, false);
    dh = __builtin_amdgcn_sdot8((int)r.z, (int)q.hn[2], dh, false); dl = __builtin_amdgcn_sdot8((int)r.z, (int)q.ln[2], dl, false);
    dh = __builtin_amdgcn_sdot8((int)r.w, (int)q.hn[3], dh, false); dl = __builtin_amdgcn_sdot8((int)r.w, (int)q.ln[3], dl, false);
    return (dh << 4) + dl;
}
__device__ __forceinline__ int red8_index(int lane) { return (lane & 4) | ((lane & 1) << 1) | ((lane >> 1) & 1); }
__device__ __forceinline__ int reduce8x8i(const int (&d)[8], int lane) {
    const bool b2 = (lane & 4) != 0, b0 = (lane & 1) != 0, b1 = (lane & 2) != 0;
    int k4[4], k2[2];
#pragma unroll
    for (int i = 0; i < 4; ++i) { const int keep = b2 ? d[4 + i] : d[i], send = b2 ? d[i] : d[4 + i]; k4[i] = keep + dpp_i<0x141>(send); }
#pragma unroll
    for (int i = 0; i < 2; ++i) { const int keep = b0 ? k4[2 + i] : k4[i], send = b0 ? k4[i] : k4[2 + i]; k2[i] = keep + dpp_i<0xB1>(send); }
    const int keep = b1 ? k2[1] : k2[0], send = b1 ? k2[0] : k2[1];
    return keep + dpp_i<0x4E>(send);
}
__device__ __forceinline__ void p7a_compute(const u32x4 (&r)[8], const P7aX& q, _Float16* pd_t, int half, int e8, int lane) {
    int d[8];
#pragma unroll
    for (int j = 0; j < 8; ++j) d[j] = dot32_i4(r[j], q);
    const int tot = reduce8x8i(d, lane);
    pd_t[16 * e8 + 8 * half + red8_index(lane)] = (_Float16)((float)tot * q.sx);
}
__device__ __forceinline__ void p7a_issue_rows(u32x4 (&r)[8], const unsigned char* tab, const LAS unsigned* ib, int e8, int boff) {
    const u32x4 o0 = *(const LAS u32x4*)(ib + 8 * e8), o1 = *(const LAS u32x4*)(ib + 8 * e8 + 4);
    const unsigned off[8] = {o0.x + boff, o0.y + boff, o0.z + boff, o0.w + boff, o1.x + boff, o1.y + boff, o1.z + boff, o1.w + boff};
    asm volatile("s_nop 4\n\tglobal_load_dwordx4 %0, %1, %2 ; P7A_LD" : "=v"(r[0]) : "v"(off[0]), "s"(tab) : "memory");
#pragma unroll
    for (int j = 1; j < 8; ++j) asm volatile("global_load_dwordx4 %0, %1, %2 ; P7A_LD" : "=v"(r[j]) : "v"(off[j]), "s"(tab) : "memory");
}
__device__ __forceinline__ void p7a_issue_idx(unsigned& ix, const int* idx, int t, int half, int lane) {
    const unsigned off = (unsigned)(t * 128 + 16 * (lane >> 3) + 8 * half + (lane & 7)) * 4u;
    asm volatile("s_nop 4\n\tglobal_load_dword %0, %1, %2 ; P7A_LD" : "=v"(ix) : "v"(off), "s"(idx) : "memory");
}
__device__ __forceinline__ void p7a_issue_x(u32x2& x, const bf16* x1b_slice, int t, int lane) {
    const unsigned off = (unsigned)t * 2048u + 8u * (unsigned)lane;
    asm volatile("s_nop 4\n\tglobal_load_dwordx2 %0, %1, %2 ; P7A_LD" : "=v"(x) : "v"(off), "s"(x1b_slice) : "memory");
}
#define P7A_WAIT_ODD(n, r, e) asm volatile("s_waitcnt vmcnt(" #n ") ; P7A_WAIT" : "+v"((r)[0]), "+v"((r)[1]), "+v"((r)[2]), "+v"((r)[3]), "+v"((r)[4]), "+v"((r)[5]), "+v"((r)[6]), "+v"((r)[7]), "+v"(e) :: "memory")
#define P7A_WAIT_EVEN(n, r, e, x) asm volatile("s_waitcnt vmcnt(" #n ") ; P7A_WAIT" : "+v"((r)[0]), "+v"((r)[1]), "+v"((r)[2]), "+v"((r)[3]), "+v"((r)[4]), "+v"((r)[5]), "+v"((r)[6]), "+v"((r)[7]), "+v"(e), "+v"(x) :: "memory")
template <int S> __device__ __forceinline__ void p7a_step(P7aState& st, int tb, int tlast, const bf16* x1b, const unsigned char* U4, const int* idx, _Float16* pd, int e8, int boff, int lane, P7aX& q,
                                                          const P7aLaneK& lk, LAS unsigned* xb) {
    LAS unsigned* ib = xb + 64;
    p7a_issue_rows(st.r[(S + 1) & 1], U4, ib + 64 * ((S + 1) & 1), e8, boff);
    { int tk = tb + P7_WPS * ((S + 5) >> 1); tk = tk < tlast ? tk : tlast; p7a_issue_idx(st.ix[(S + 1) & 3], idx, tk, (S + 5) & 1, lane); }
    const int t = tb + P7_WPS * (S >> 1);
    if ((S & 1) == 0) {
        P7A_WAIT_EVEN(10, st.r[S & 1], st.ix[(S + 2) & 3], st.x);
        ib[64 * (S & 1) + lane] = st.ix[(S + 2) & 3] << 7;
        p7a_quant_x(q, st.x, lk, xb, lane);
        int tk = t + P7_WPS; tk = tk < tlast ? tk : tlast;
        p7a_issue_x(st.x, x1b, tk, lane);
    } else {
        P7A_WAIT_ODD(11, st.r[S & 1], st.ix[(S + 2) & 3]);
        ib[64 * (S & 1) + lane] = st.ix[(S + 2) & 3] << 7;
    }
    p7a_compute(st.r[S & 1], q, pd + (size_t)t * 128, S & 1, e8, lane);
}
__device__ __forceinline__ void p7a_phase(int slice, int wrank, const bf16* x1b, const unsigned char* U4, const int* idx, _Float16* PD, int lane, LAS unsigned* xb) {
    const int e8 = lane >> 3, boff = 16 * (lane & 7);
    _Float16* pd = PD + (size_t)slice * T * 128;
    const int tlast = wrank + P7_WPS * 63;
    U4 += (size_t)slice * P7_SLICE_BYTES; x1b += 256 * slice;
    const bool odd = (lane & 1) != 0;
    const P7aLaneK lk = {odd ? 0u : 4u, odd ? 0xf0f0f0f0u : 0x0f0f0f0fu, odd ? 4u : 0u, odd ? 0xf0f0f0f0u : 0x0f0f0f0fu, odd ? 0x80808080u : 0x08080808u};
    LAS unsigned* ib = xb + 64;
    P7aState st; P7aX q;
    p7a_issue_idx(st.ix[0], idx, wrank, 0, lane); p7a_issue_idx(st.ix[1], idx, wrank, 1, lane); p7a_issue_idx(st.ix[2], idx, wrank + P7_WPS, 0, lane); p7a_issue_idx(st.ix[3], idx, wrank + P7_WPS, 1, lane);
    p7a_issue_x(st.x, x1b, wrank, lane);
    asm volatile("s_waitcnt vmcnt(0) ; P7A_WAIT" : "+v"(st.ix[0]), "+v"(st.ix[1]), "+v"(st.ix[2]), "+v"(st.ix[3]), "+v"(st.x) :: "memory");
    ib[lane] = st.ix[0] << 7; ib[64 + lane] = st.ix[1] << 7;
    p7a_issue_rows(st.r[0], U4, ib, e8, boff);
    p7a_issue_idx(st.ix[0], idx, wrank + 2 * P7_WPS, 0, lane);
#pragma unroll 1
    for (int it = 0; it < 16; ++it) {
        const int tb = wrank + 4 * P7_WPS * it;
        p7a_step<0>(st, tb, tlast, x1b, U4, idx, pd, e8, boff, lane, q, lk, xb); p7a_step<1>(st, tb, tlast, x1b, U4, idx, pd, e8, boff, lane, q, lk, xb);
        p7a_step<2>(st, tb, tlast, x1b, U4, idx, pd, e8, boff, lane, q, lk, xb); p7a_step<3>(st, tb, tlast, x1b, U4, idx, pd, e8, boff, lane, q, lk, xb);
        p7a_step<4>(st, tb, tlast, x1b, U4, idx, pd, e8, boff, lane, q, lk, xb); p7a_step<5>(st, tb, tlast, x1b, U4, idx, pd, e8, boff, lane, q, lk, xb);
        p7a_step<6>(st, tb, tlast, x1b, U4, idx, pd, e8, boff, lane, q, lk, xb); p7a_step<7>(st, tb, tlast, x1b, U4, idx, pd, e8, boff, lane, q, lk, xb);
    }
    asm volatile("s_waitcnt vmcnt(0) ; P7A_WAIT" : "+v"(st.r[0][0]), "+v"(st.r[0][1]), "+v"(st.r[0][2]), "+v"(st.r[0][3]), "+v"(st.r[0][4]), "+v"(st.r[0][5]), "+v"(st.r[0][6]), "+v"(st.r[0][7]),
                 "+v"(st.ix[0]), "+v"(st.ix[1]), "+v"(st.ix[2]), "+v"(st.ix[3]), "+v"(st.x) :: "memory");
}
struct P7bIn { float s0, s1, g0, g1, rs; int e0, e1; };
__device__ __forceinline__ void p7b_load(P7bIn& in, int t, const _Float16* PD, const int* idx, const float* gw, const float* rstd, int lane) {
    float s0 = 0.f, s1 = 0.f;
#pragma unroll
    for (int sl = 0; sl < P7_NS; ++sl) { const _Float16* p = PD + ((size_t)sl * T + t) * 128; s0 += (float)p[lane]; s1 += (float)p[lane + 64]; }
    in.s0 = s0; in.s1 = s1; in.e0 = idx[(size_t)t * 128 + lane]; in.e1 = idx[(size_t)t * 128 + 64 + lane];
    in.g0 = gw[(size_t)t * 128 + lane]; in.g1 = gw[(size_t)t * 128 + 64 + lane]; in.rs = rstd[t];
}
__device__ __forceinline__ void p7b_finish(const P7bIn& in, float su0, float su1, float sv0, float sv1, int t, float* gw, int lane) {
    const float z0 = in.s0 * su0 * in.rs, z1 = in.s1 * su1 * in.rs;
    const float a0 = 0.5f * z0 * (1.f + erff(z0 * 0.70710678118654752f)), a1 = 0.5f * z1 * (1.f + erff(z1 * 0.70710678118654752f));
    float* g = gw + (size_t)t * 128;
    g[lane] = in.g0 * sv0 * a0; g[lane + 64] = in.g1 * sv1 * a1;
}
__device__ __forceinline__ void p7b_phase(int gw_, int NGW, const _Float16* PD, const int* idx, float* gw, const float* SU, const float* SV, const float* rstd, int lane, LAS float* sl, int tid) {
    { const f32x4* s4 = (const f32x4*)SU; const f32x4* v4 = (const f32x4*)SV; LAS f32x4* l4 = (LAS f32x4*)sl;
#pragma unroll 4
      for (int i = tid; i < 4096; i += NTHREADS) { l4[i] = s4[i]; l4[4096 + i] = v4[i]; } }
    __syncthreads();
    const LAS float* SUl = sl; const LAS float* SVl = sl + 16384;
    P7bIn cur, nxt;
    p7b_load(cur, gw_, PD, idx, gw, rstd, lane);
    for (int t = gw_; t < T; t += NGW) {
        const int tn = t + NGW < T ? t + NGW : t;
        const float su0 = SUl[cur.e0], su1 = SUl[cur.e1], sv0 = SVl[cur.e0], sv1 = SVl[cur.e1];
        p7b_load(nxt, tn, PD, idx, gw, rstd, lane);
        p7b_finish(cur, su0, su1, sv0, sv1, t, gw, lane);
        cur = nxt;
    }
}
__device__ __forceinline__ void p7_load_cf(float (&cf)[8], const float* gw, int t, int half, int e8) {
    const f32x4* p = (const f32x4*)(gw + (size_t)t * 128 + 16 * e8 + 8 * half);
    const f32x4 v0 = p[0], v1 = p[1];
    cf[0] = v0.x; cf[1] = v0.y; cf[2] = v0.z; cf[3] = v0.w; cf[4] = v1.x; cf[5] = v1.y; cf[6] = v1.z; cf[7] = v1.w;
}
__device__ __forceinline__ void p7c_load_idx(int (&ex)[8], const int* idx, int wtok, int q) {
    const int4* p = (const int4*)(idx + (size_t)(wtok + 4096 * (q >> 4)) * 128 + 8 * (q & 15));
    const int4 v0 = p[0], v1 = p[1];
    ex[0] = v0.x; ex[1] = v0.y; ex[2] = v0.z; ex[3] = v0.w; ex[4] = v1.x; ex[5] = v1.y; ex[6] = v1.z; ex[7] = v1.w;
}
__device__ __forceinline__ void p7c_load_cf(float (&cf)[8], const float* gw, int wtok, int q) {
    const f32x4* p = (const f32x4*)(gw + (size_t)(wtok + 4096 * (q >> 4)) * 128 + 8 * (q & 15));
    const f32x4 v0 = p[0], v1 = p[1];
    cf[0] = v0.x; cf[1] = v0.y; cf[2] = v0.z; cf[3] = v0.w; cf[4] = v1.x; cf[5] = v1.y; cf[6] = v1.z; cf[7] = v1.w;
}
__device__ __forceinline__ void p7c_finish(const f32x2 (&acc)[16], const bf16* x1b_t, bf16* x2b_t, float* ssq2_t, int col0, int lane) {
    const u32x4* xp = (const u32x4*)(x1b_t + col0); u32x4* op = (u32x4*)(x2b_t + col0);
    float ss = 0.f;
#pragma unroll
    for (int i = 0; i < 4; ++i) { const u32x4 xv = xp[i];
        const float y0 = bf_lo(xv.x) + acc[4 * i].x, y1 = bf_hi(xv.x) + acc[4 * i].y, y2 = bf_lo(xv.y) + acc[4 * i + 1].x, y3 = bf_hi(xv.y) + acc[4 * i + 1].y;
        const float y4 = bf_lo(xv.z) + acc[4 * i + 2].x, y5 = bf_hi(xv.z) + acc[4 * i + 2].y, y6 = bf_lo(xv.w) + acc[4 * i + 3].x, y7 = bf_hi(xv.w) + acc[4 * i + 3].y;
        u32x4 w; w.x = pk2(y0, y1); w.y = pk2(y2, y3); w.z = pk2(y4, y5); w.w = pk2(y6, y7);
        op[i] = w;
        ss += ((y0 * y0 + y1 * y1) + (y2 * y2 + y3 * y3)) + ((y4 * y4 + y5 * y5) + (y6 * y6 + y7 * y7)); }
    ss += dpp_f<0xB1>(ss); ss += dpp_f<0x4E>(ss); ss += dpp_f<0x141>(ss);
    if ((lane & 7) == 0) *ssq2_t = ss;
}
struct P7cState { int ex[4][8]; u32x4 r[2][8]; float cf[4][8]; };
template <int S> __device__ __forceinline__ void p7c_step(P7cState& st, int q0, int wtok, const bf16* x1b, bf16* xio, const unsigned char* V4, const int* idx, const float* gw, float* sq, int boff, int lane, f32x2 (&acc)[16]) {
    const int q = q0 + S;
    p7_issue_rows(st.r[(S + 1) & 1], V4, st.ex[(S + 1) & 3], boff);
    { const int qq = q + 5 < 127 ? q + 5 : 127; p7c_load_idx(st.ex[(S + 1) & 3], idx, wtok, qq); }
    if (S == 0 && (q0 & 8) == 0) {
#pragma unroll
        for (int k = 0; k < 16; ++k) acc[k] = (f32x2){0.f, 0.f};
    }
#pragma unroll
    for (int j = 0; j < 8; ++j) axpy32_fp4(acc, st.cf[S & 3][j], st.r[S & 1][j]);
    { const int qq = q + 4 < 127 ? q + 4 : 127; p7c_load_cf(st.cf[S & 3], gw, wtok, qq); }
    if (S == 7 && (q0 & 8) != 0) { const int t = wtok + 4096 * (q >> 4);
        p7c_finish(acc, x1b + (size_t)t * 1024, xio + (size_t)t * 1024, sq + t, 2 * boff, lane); }
}
__device__ __forceinline__ void p7c_phase(int slice, int wrank, const bf16* x1b, bf16* xio, const unsigned char* V4, const int* idx, const float* gw, float* SSQ2, int lane) {
    const int boff = 16 * (lane & 7), wtok = 8 * wrank + (lane >> 3);
    float* sq = SSQ2 + (size_t)slice * T;
    V4 += (size_t)slice * P7_SLICE_BYTES; xio += 256 * slice; x1b += 256 * slice;
    P7cState st; f32x2 acc[16];
    p7c_load_idx(st.ex[0], idx, wtok, 0); p7c_load_idx(st.ex[1], idx, wtok, 1); p7c_load_idx(st.ex[2], idx, wtok, 2); p7c_load_idx(st.ex[3], idx, wtok, 3);
    p7c_load_cf(st.cf[0], gw, wtok, 0); p7c_load_cf(st.cf[1], gw, wtok, 1); p7c_load_cf(st.cf[2], gw, wtok, 2); p7c_load_cf(st.cf[3], gw, wtok, 3);
    p7_issue_rows(st.r[0], V4, st.ex[0], boff);
    p7c_load_idx(st.ex[0], idx, wtok, 4);
#pragma unroll 1
    for (int it = 0; it < 16; ++it) {
        const int q0 = 8 * it;
        p7c_step<0>(st, q0, wtok, x1b, xio, V4, idx, gw, sq, boff, lane, acc); p7c_step<1>(st, q0, wtok, x1b, xio, V4, idx, gw, sq, boff, lane, acc);
        p7c_step<2>(st, q0, wtok, x1b, xio, V4, idx, gw, sq, boff, lane, acc); p7c_step<3>(st, q0, wtok, x1b, xio, V4, idx, gw, sq, boff, lane, acc);
        p7c_step<4>(st, q0, wtok, x1b, xio, V4, idx, gw, sq, boff, lane, acc); p7c_step<5>(st, q0, wtok, x1b, xio, V4, idx, gw, sq, boff, lane, acc);
        p7c_step<6>(st, q0, wtok, x1b, xio, V4, idx, gw, sq, boff, lane, acc); p7c_step<7>(st, q0, wtok, x1b, xio, V4, idx, gw, sq, boff, lane, acc);
    }
}
__device__ __forceinline__ void p7d_phase(int gw_, int NGW, const bf16* x2b, float* out, const float* SSQ2, const float* nf, int lane) {
    f32x4 g[4];
#pragma unroll
    for (int j = 0; j < 4; ++j) g[j] = ((const f32x4*)nf)[lane + 64 * j];
    u32x2 v[4], vn[4]; float s, sn;
    { const u32x2* xr = (const u32x2*)(x2b + (size_t)gw_ * 1024) + lane;
#pragma unroll
      for (int j = 0; j < 4; ++j) v[j] = xr[64 * j];
      s = 0.f;
#pragma unroll
      for (int sl = 0; sl < P7_NS; ++sl) s += SSQ2[(size_t)sl * T + gw_]; }
    for (int t = gw_; t < T; t += NGW) {
        const int tn = t + NGW < T ? t + NGW : t;
        { const u32x2* xr = (const u32x2*)(x2b + (size_t)tn * 1024) + lane;
#pragma unroll
          for (int j = 0; j < 4; ++j) vn[j] = xr[64 * j];
          sn = 0.f;
#pragma unroll
          for (int sl = 0; sl < P7_NS; ++sl) sn += SSQ2[(size_t)sl * T + tn]; }
        const float r2 = rsqrtf(s * (1.f / D) + RMS_EPS);
        f32x4* yr = (f32x4*)(out + (size_t)t * 1024) + lane;
#pragma unroll
        for (int j = 0; j < 4; ++j) yr[64 * j] = (f32x4){bf_lo(v[j].x) * r2 * g[j].x, bf_hi(v[j].x) * r2 * g[j].y, bf_lo(v[j].y) * r2 * g[j].z, bf_hi(v[j].y) * r2 * g[j].w};
#pragma unroll
        for (int j = 0; j < 4; ++j) v[j] = vn[j];
        s = sn;
    }
}

#define XB_TMO      128
#define XB_XCNT(j)  (256  + 64 * (j))
#define XB_XSUB(j)  (1280 + 64 * (j))
#define XB_XGEN(j)  (2304 + 64 * (j))
#define XB_TOP      3328
#define XB_TOPGEN   3392
#define XCD_BAR_WORDS 3456
#define XB_SPIN_CAP (1u << 18)

__device__ __forceinline__ unsigned xb_ld(unsigned* p)              { return __hip_atomic_load(p, __ATOMIC_RELAXED, __HIP_MEMORY_SCOPE_AGENT); }
__device__ __forceinline__ unsigned xb_add(unsigned* p, unsigned v) { return __hip_atomic_fetch_add(p, v, __ATOMIC_RELAXED, __HIP_MEMORY_SCOPE_AGENT); }
__device__ __forceinline__ unsigned xb_xcc_id() { return (unsigned)__builtin_amdgcn_s_getreg((3 << 11) | 20) & 0xFu; }
#define XB_SPIN(cond, bar) do { unsigned _sp = 0; while (cond) { __builtin_amdgcn_s_sleep(1); \
    if ((++_sp & 255u) == 0u) { if (xb_ld(&(bar)[XB_TMO])) break; if (_sp > XB_SPIN_CAP) { atomicAdd(&(bar)[XB_TMO], 1u); break; } } } } while (0)

struct XcdBarrier {
    unsigned* bar; unsigned x;
    volatile LAS unsigned* st;
};

__device__ __forceinline__ XcdBarrier xcd_barrier_post(unsigned* bar, volatile LAS unsigned* st) {
    XcdBarrier b; b.bar = bar; b.x = xb_xcc_id(); b.st = st;
    if (threadIdx.x == 0) (void)xb_add(&bar[XB_XCNT(b.x)], 1u);
    return b;
}
__device__ __forceinline__ void xcd_barrier_complete(unsigned* bar, unsigned x, unsigned& nloc, unsigned& nx) {
    const unsigned G = gridDim.x * gridDim.y * gridDim.z;
    unsigned sum, cnt, mine, sp = 0u;
    for (;;) {
        sum = 0u; cnt = 0u; mine = 0u;
#pragma unroll
        for (unsigned j = 0; j < 16; ++j) { const unsigned c = xb_ld(&bar[XB_XCNT(j)]); sum += c; cnt += (c > 0u) ? 1u : 0u; mine = (j == x) ? c : mine; }
        if (sum == G) break;
        __builtin_amdgcn_s_sleep(1);
        if ((++sp & 255u) == 0u) { if (xb_ld(&bar[XB_TMO])) break; if (sp > XB_SPIN_CAP) { atomicAdd(&bar[XB_TMO], 1u); break; } }
    }
    nloc = mine > 0u ? mine : 1u; nx = cnt > 0u ? cnt : 1u;
}

__device__ __forceinline__ void xcd_barrier(const XcdBarrier& b) {
    asm volatile("s_waitcnt vmcnt(0)" ::: "memory");
    __syncthreads();
    if (threadIdx.x == 0) {
        unsigned* bar = b.bar;
        __builtin_amdgcn_s_waitcnt(0);
        unsigned nloc = b.st[0], nx = b.st[1];
        if (nloc == 0u) { xcd_barrier_complete(bar, b.x, nloc, nx); b.st[0] = nloc; b.st[1] = nx; }
        const unsigned old = xb_add(&bar[XB_XSUB(b.x)], 1u);
        const unsigned gen = old / nloc;
        if (old + 1u == (gen + 1u) * nloc) {
            __builtin_amdgcn_fence(__ATOMIC_RELEASE, "agent");
            asm volatile("s_waitcnt vmcnt(0)" ::: "memory");
            const unsigned og = xb_add(&bar[XB_TOP], 1u);
            const unsigned tg = og / nx;
            if (og + 1u == (tg + 1u) * nx) xb_add(&bar[XB_TOPGEN], 1u);
            else XB_SPIN(xb_ld(&bar[XB_TOPGEN]) == tg, bar);
            __builtin_amdgcn_fence(__ATOMIC_ACQUIRE, "agent");
            xb_add(&bar[XB_XGEN(b.x)], 1u);
            asm volatile("s_waitcnt vmcnt(0)" ::: "memory");
        } else {
            XB_SPIN(xb_ld(&bar[XB_XGEN(b.x)]) == gen, bar);
            __builtin_amdgcn_fence(__ATOMIC_ACQUIRE, "agent");
            asm volatile("s_waitcnt vmcnt(0)" ::: "memory");
        }
    }
    __syncthreads();
}

struct Params { const float* in[13]; float* out; unsigned char* ws; };

__global__ void __launch_bounds__(NTHREADS, 2) fwd_kernel(Params p) {
    extern __shared__ __attribute__((aligned(16))) unsigned char lds_raw[];
    cg::grid_group grid = cg::this_grid();
    LAS unsigned char* lds = (LAS unsigned char*)lds_raw;
    const int tid = threadIdx.x, lane = tid & 63, wave = __builtin_amdgcn_readfirstlane(tid >> 6);
    const int G = gridDim.x, gw = blockIdx.x * NWAVES + wave, NGW = G * NWAVES;
    unsigned char* ws = p.ws;
    const float* x = p.in[0]; const float* norm_mix = p.in[1]; const float* w_in = p.in[2]; const float* w_sb = p.in[3]; const float* w_ca = p.in[4];
    const float* relb = p.in[5]; const float* w_out = p.in[6]; const float* norm_ffn = p.in[7]; const float* wq = p.in[8]; const float* subk = p.in[9];
    const float* pu = p.in[10]; const float* pv = p.in[11]; const float* norm_final = p.in[12];
    float* ssq = (float*)(ws + WS_SSQ);
    bf16* Win_t = (bf16*)(ws + WS_WIN); bf16* Psb_t = (bf16*)(ws + WS_PSB); bf16* Pca_t = (bf16*)(ws + WS_PCA); bf16* Wout_t = (bf16*)(ws + WS_WOUT); bf16* Wsc_t = (bf16*)(ws + WS_WSC);
    unsigned char* U8 = ws + WS_U; unsigned char* V8 = ws + WS_V; float* SU = (float*)(ws + WS_SU); float* SV = (float*)(ws + WS_SV); float* rstd2 = (float*)(ws + WS_RSTD); float* SSQ2 = (float*)(ws + WS_SSQ2);
    int* eidx = (int*)(ws + WS_IDX); float* egw = (float*)(ws + WS_GW);
    bf16* S0 = (bf16*)(ws + WS_SLOT0); bf16* S1 = (bf16*)(ws + WS_SLOT0 + SLOT); bf16* S2 = (bf16*)(ws + WS_SLOT0 + 2 * SLOT); bf16* S3 = (bf16*)(ws + WS_SLOT0 + 3 * SLOT);
    bf16* S4 = (bf16*)(ws + WS_SLOT0 + 4 * SLOT); bf16* S5 = (bf16*)(ws + WS_SLOT0 + 5 * SLOT);
    bf16* o_sb = S0; bf16* o_ca = S0 + 512;
    bf16* xbf = (bf16*)p.out;
    unsigned short* scores = (unsigned short*)S1;

    unsigned* barw = (unsigned*)ws;
    volatile LAS unsigned* bst = (volatile LAS unsigned*)(lds + LDS_MISC_OFF);
    if (tid < 2) bst[tid] = 0u;
    __syncthreads();
    const XcdBarrier xb = xcd_barrier_post(barw, bst);
    if (p.ws == nullptr) grid.sync();
    {
        LAS float* scr = (LAS float*)(lds + wave * 16384);
        constexpr int I_IN = (1024 / 64) * (5120 / 32), I_SB = (512 / 64) * (1024 / 32), I_OUT = (1024 / 64) * (1024 / 32), I_WSC = 2048;
        constexpr int NITEMS = I_IN + 2 * I_SB + I_OUT + I_WSC;
        for (int it = gw; it < NITEMS; it += NGW) {
            int r = it;
            if (r < I_WSC) { p0_wsc_item(wq, subk, norm_ffn, Wsc_t, r, lane); continue; } r -= I_WSC;
            if (r < I_IN) { p0_transpose_item(w_in, 1024, 5120, Win_t, scr, r, lane); continue; } r -= I_IN;
            if (r < I_SB) { p0_transpose_item(w_sb, 512, 1024, Psb_t, scr, r, lane, 1024); continue; } r -= I_SB;
            if (r < I_SB) { p0_transpose_item(w_ca, 512, 1024, Psb_t + 512, scr, r, lane, 1024); continue; } r -= I_SB;
            p0_transpose_item(w_out, 1024, 1024, Wout_t, scr, r, lane);
        }
        { f32x4 va[4], vb[4], na[4], nb[4];
          constexpr int NR1 = T;
          row_load16(va, x + (size_t)gw * D, lane); row_load16(vb, x + (size_t)(gw + NGW < NR1 ? gw + NGW : gw) * D, lane);
          for (int m = gw; m < NR1; m += 2 * NGW) {
              const int mb = m + NGW, ma2 = m + 2 * NGW < NR1 ? m + 2 * NGW : m, mb2 = m + 3 * NGW < NR1 ? m + 3 * NGW : m;
              row_load16(na, x + (size_t)ma2 * D, lane); row_load16(nb, x + (size_t)mb2 * D, lane);
              rms_row_finish(va, norm_mix, S0 + (size_t)m * D, xbf + (size_t)m * D, lane);
              if (mb < NR1) rms_row_finish(vb, norm_mix, S0 + (size_t)mb * D, xbf + (size_t)mb * D, lane);
#pragma unroll
              for (int j = 0; j < 4; ++j) { va[j] = na[j]; vb[j] = nb[j]; }
          }
          constexpr int NR2 = 2 * 16384;
#define TABROW(r_) ((r_) < 16384 ? pu + (size_t)(r_) * 1024 : pv + (size_t)((r_) - 16384) * 1024)
#define TABFIN(v_, r_) do { if ((r_) < 16384) int4_row_finish(v_, norm_ffn, U8 + (size_t)(r_) * 128, SU + (r_), lane); else fp8_row_finish(v_, nullptr, V8 + (size_t)((r_) - 16384) * 128, SV + ((r_) - 16384), lane); } while (0)
          fp8_row_load(va, TABROW(gw), lane); { const int r1 = gw + NGW < NR2 ? gw + NGW : gw; fp8_row_load(vb, TABROW(r1), lane); }
          for (int r = gw; r < NR2; r += 2 * NGW) {
              const int rb = r + NGW, ra2 = r + 2 * NGW < NR2 ? r + 2 * NGW : r, rb2 = r + 3 * NGW < NR2 ? r + 3 * NGW : r;
              fp8_row_load(na, TABROW(ra2), lane); fp8_row_load(nb, TABROW(rb2), lane);
              TABFIN(va, r);
              if (rb < NR2) TABFIN(vb, rb);
#pragma unroll
              for (int j = 0; j < 4; ++j) { va[j] = na[j]; vb[j] = nb[j]; }
          }
#undef TABROW
#undef TABFIN
        }
    }
    xcd_barrier(xb);
    {
        pg8::Gemm g{S0, Win_t, T, 5120, 1024}; pg8::StaticOrder S; S.init(T, 5120, G, (int)blockIdx.x);
        pg8::EpiBf16<0> E{S1, 1024, nullptr, 1024, SLOT / 2, 1.f};
        pg8::gemm_phase<pg8::EpiBf16<0>, pg8::StaticOrder, true, true>(lds, g, S, E);
    }
    xcd_barrier(xb);
    {
        LAS float* biasl = (LAS float*)(lds + LDS_BIAS_OFF);
        for (int i = tid; i < 8 * 257; i += NTHREADS) biasl[i] = relb[i] * LOG2E;
        __syncthreads();
        for (int u = blockIdx.x; u < 2048; u += G) {
            if (u < 1024) ca_wg_unit(u, lds, biasl, S2, S3, o_ca, wave, lane);
            else sb_wg_unit(u - 1024, lds, S1, S2, o_sb, wave, lane);
        }
        asm volatile("s_waitcnt vmcnt(0)" ::: "memory");
    }
    xcd_barrier(xb);
    {
        pg8::Gemm g{S0, Psb_t, T, 1024, 1024}; pg8::StaticOrder S; S.init(T, 1024, G, (int)blockIdx.x);
        EpiGateAB E{S4, S5, S2};
        pg8::gemm_phase<EpiGateAB, pg8::StaticOrder, true, true>(lds, g, S, E);
    }
    xcd_barrier(xb);
    {
        pg8::Gemm g{S2, Wout_t, T, 1024, 1024}; pg8::StaticOrder S; S.init(T, 1024, G, (int)blockIdx.x);
        EpiResid E{xbf, S0, ssq};
        pg8::gemm_phase<EpiResid, pg8::StaticOrder, true, true>(lds, g, S, E);
    }
    xcd_barrier(xb);
    {
        pg8::Gemm g{S0, Wsc_t, T, 2048, 1024}; pg8::StaticOrder S; S.init(T, 2048, G, (int)blockIdx.x);
        LAS float* rl = (LAS float*)(lds + 131072);
        for (int i = tid >> 8; ; i += 2) { pg8::Unit u; if (!S.next(i, u) || i >= 16) break;
            const int row = u.pm * 256 + (tid & 255);
            const f32x4* sp = (const f32x4*)(ssq + (size_t)row * 16); const f32x4 s0 = sp[0], s1 = sp[1], s2 = sp[2], s3 = sp[3];
            const float tot = ((s0.x + s0.y) + (s0.z + s0.w)) + ((s1.x + s1.y) + (s1.z + s1.w)) + ((s2.x + s2.y) + (s2.z + s2.w)) + ((s3.x + s3.y) + (s3.z + s3.w));
            rl[256 * i + (tid & 255)] = rsqrtf(tot * (1.f / 1024.f) + RMS_EPS); }
        __syncthreads();
        EpiScore E{rl, scores, 0};
        pg8::gemm_phase<EpiScore, pg8::StaticOrder, true, true>(lds, g, S, E);
        for (int j = wave; ; j += NWAVES) {
            pg8::Unit u; if (!S.next(j >> 2, u)) break;
            topk_task((4 * u.pm + (j & 3)) * 8 + u.pn, scores, eidx, egw, (LAS int*)(lds + wave * 16384), lane);
        }
        for (int t = blockIdx.x * NTHREADS + tid; t < T; t += G * NTHREADS) {
            const f32x4* sp = (const f32x4*)(ssq + (size_t)t * 16); const f32x4 s0 = sp[0], s1 = sp[1], s2 = sp[2], s3 = sp[3];
            const float tot = ((s0.x + s0.y) + (s0.z + s0.w)) + ((s1.x + s1.y) + (s1.z + s1.w)) + ((s2.x + s2.y) + (s2.z + s2.w)) + ((s3.x + s3.y) + (s3.z + s3.w));
            rstd2[t] = rsqrtf(tot * (1.f / 1024.f) + RMS_EPS);
        }
    }
    xcd_barrier(xb);
    {
        _Float16* PD = (_Float16*)S3;
        const bool sliced = (G % 4 == 0) && (G / 4 * NWAVES == P7_WPS);
        const int slice = blockIdx.x & 3, wrank = (blockIdx.x >> 2) * NWAVES + wave;
        if (sliced) p7a_phase(slice, wrank, S0, U8, eidx, PD, lane, (LAS unsigned*)(lds + wave * 1024));
        xcd_barrier(xb);
        if (sliced) p7b_phase(gw, NGW, PD, eidx, egw, SU, SV, rstd2, lane, (LAS float*)lds, tid);
        xcd_barrier(xb);
        if (sliced) p7c_phase(slice, wrank, S0, S4, V8, eidx, egw, SSQ2, lane);
        xcd_barrier(xb);
        if (sliced) p7d_phase(gw, NGW, S4, p.out, SSQ2, norm_final, lane);
    }
}

extern "C" void kernel_launch(void* const* d_in, const int* in_sizes, int n_in, void* d_out, int out_size, void* d_ws, size_t ws_size, hipStream_t stream) {
    static int grid = 0;
    if (grid == 0) {
        if (n_in != 13 || in_sizes[0] != T * D || out_size != T * D || ws_size < WS_END) {
            fprintf(stderr, "kernel_launch: built for 13 inputs, x/out of %d floats, >= %zu bytes of workspace; got n_in %d, in0 %d, out %d, ws %zu; nothing launched\n", T * D, (size_t)WS_END, n_in, n_in > 0 ? in_sizes[0] : -1, out_size, ws_size);
            grid = -1; return; }
        int dev = 0, cus = 0, per_cu = 0;
        if (hipGetDevice(&dev) != hipSuccess || hipDeviceGetAttribute(&cus, hipDeviceAttributeMultiprocessorCount, dev) != hipSuccess) { fprintf(stderr, "kernel_launch: device query failed\n"); grid = -1; return; }
        if (hipFuncSetAttribute((const void*)fwd_kernel, hipFuncAttributeMaxDynamicSharedMemorySize, LDS_BYTES) != hipSuccess) { fprintf(stderr, "kernel_launch: hipFuncSetAttribute failed\n"); grid = -1; return; }
        if (hipOccupancyMaxActiveBlocksPerMultiprocessor(&per_cu, (const void*)fwd_kernel, NTHREADS, LDS_BYTES) != hipSuccess || per_cu < 1) { fprintf(stderr, "kernel_launch: occupancy query says %d blocks per CU\n", per_cu); (void)hipGetLastError(); grid = -1; return; }
        grid = cus * 1;
    }
    if (grid < 0) return;
    if (hipMemsetAsync(d_ws, 0, 16384, stream) != hipSuccess) { fprintf(stderr, "kernel_launch: hipMemsetAsync of the barrier words failed\n"); return; }
    Params p{};
    for (int i = 0; i < 13; ++i) p.in[i] = (const float*)d_in[i];
    p.out = (float*)d_out; p.ws = (unsigned char*)d_ws;
    void* args[] = {&p};
    hipError_t e = hipLaunchCooperativeKernel((const void*)fwd_kernel, dim3(grid), dim3(NTHREADS), args, LDS_BYTES, stream);
    if (e != hipSuccess) fprintf(stderr, "kernel_launch: cooperative launch failed: %s (grid %d)\n", hipGetErrorString(e), grid);
}
```
